# Optimizing an MI355X kernel written in HIP

```python
import jax, jax.numpy as jnp
from jax import lax
import numpy as np

D_MODEL = 1024
BATCH = 32
SEQ = 2048
DEPTH = 1

N_MEM = 256
MIX_WIDTH = D_MODEL
POOL_WIDTH = MIX_WIDTH // 2
POOL_GROUPS = 4
POOL_GROUP_DIM = POOL_WIDTH // POOL_GROUPS
POOL_WINDOWS = (2, 4, 8, 16)
GLA_VALUE_WIDTH = MIX_WIDTH - POOL_WIDTH
GLA_KEY_WIDTH = GLA_VALUE_WIDTH // 2
GLA_HEADS = 4
GLA_DK = GLA_KEY_WIDTH // GLA_HEADS
GLA_DV = GLA_VALUE_WIDTH // GLA_HEADS
GLA_GATE_RANK = 16
GLA_GATE_NORMALIZER = 16.0
GLA_CHUNK = 64
OFF_Q = POOL_WIDTH
OFF_K = OFF_Q + GLA_KEY_WIDTH
OFF_V = OFF_K + GLA_KEY_WIDTH
OFF_G = OFF_V + GLA_VALUE_WIDTH
OFF_R = OFF_G + GLA_GATE_RANK
IN_PROJ_WIDTH = OFF_R + GLA_VALUE_WIDTH
XATTN_HEADS = 4
XATTN_HEAD_DIM = D_MODEL // XATTN_HEADS
D_FF = 2816
CONV_WIDTH = 3
EPS = 1e-6

kernel_name = 'hybrid_pool_gla_memxattn_convffn'


def rms_norm(x, w):
    x32 = x.astype(jnp.float32)
    y = x32 * lax.rsqrt(jnp.mean(x32 * x32, axis=-1, keepdims=True) + EPS)
    return (y * w.astype(jnp.float32)).astype(x.dtype)


def multiscale_pool(p, pool_w, pool_scale):
    b, s, _ = p.shape
    pg = p.reshape(b, s, POOL_GROUPS, POOL_GROUP_DIM)
    cs = jnp.cumsum(pg.astype(jnp.float32), axis=1)
    t = jnp.arange(s)
    pooled = []
    for g, w in enumerate(POOL_WINDOWS):
        c = cs[:, :, g]
        c_prev = jnp.pad(c, ((0, 0), (w, 0), (0, 0)))[:, :s]
        cnt = jnp.minimum(t + 1, w).astype(jnp.float32)[None, :, None]
        pooled.append((c - c_prev) / cnt)
    pooled = jnp.stack(pooled, axis=2).astype(p.dtype) - pg
    mixed = jnp.einsum('bsgc,gcd->bsgd', pooled, pool_w)
    return mixed.reshape(b, s, POOL_WIDTH) * pool_scale


def gla_chunked(q, k, v, log_g):
    b, h, s, dk = q.shape
    dv = v.shape[-1]
    nc = s // GLA_CHUNK
    f32 = jnp.float32
    q = q.astype(f32).reshape(b, h, nc, GLA_CHUNK, dk) * (dk ** -0.5)
    k = k.astype(f32).reshape(b, h, nc, GLA_CHUNK, dk)
    v = v.astype(f32).reshape(b, h, nc, GLA_CHUNK, dv)
    G = jnp.cumsum(log_g.astype(f32).reshape(b, h, nc, GLA_CHUNK, dk), axis=3)
    G_last = G[:, :, :, -1]
    q_dec = q * jnp.exp(G)
    k_dec = k * jnp.exp(-G)
    causal = jnp.tril(jnp.ones((GLA_CHUNK, GLA_CHUNK), dtype=bool))
    scores = jnp.where(causal, jnp.einsum('bhnid,bhnjd->bhnij', q_dec, k_dec), 0.0)
    o_intra = jnp.einsum('bhnij,bhnje->bhnie', scores, v)
    k_to_end = k * jnp.exp(G_last[:, :, :, None] - G)
    chunk_kv = jnp.einsum('bhnjd,bhnje->bhnde', k_to_end, v)
    decay = jnp.exp(G_last)

    def step(state, inp):
        dec, kv = inp
        return state * dec[..., None] + kv, state

    init = jnp.zeros((b, h, dk, dv), f32)
    _, prev_states = lax.scan(step, init, (jnp.moveaxis(decay, 2, 0), jnp.moveaxis(chunk_kv, 2, 0)))
    prev_states = jnp.moveaxis(prev_states, 0, 2)
    o_inter = jnp.einsum('bhnid,bhnde->bhnie', q_dec, prev_states)
    return (o_intra + o_inter).reshape(b, h, s, dv)


def hybrid_mixer(h, w_in, pool_w, pool_scale, gk_w2, gk_b, gla_norm_w, w_out):
    b, s, _ = h.shape
    proj = h @ w_in
    p = proj[..., :OFF_Q]
    q = proj[..., OFF_Q:OFF_K]
    k = proj[..., OFF_K:OFF_V]
    v = proj[..., OFF_V:OFF_G]
    g_low = proj[..., OFF_G:OFF_R]
    r = proj[..., OFF_R:]
    pool_out = multiscale_pool(p, pool_w, pool_scale)
    log_g = jax.nn.log_sigmoid((g_low @ gk_w2 + gk_b).astype(jnp.float32)) / GLA_GATE_NORMALIZER

    def heads(t, d):
        return t.reshape(b, s, GLA_HEADS, d).transpose(0, 2, 1, 3)

    o = gla_chunked(heads(q, GLA_DK), heads(k, GLA_DK), heads(v, GLA_DV), heads(log_g, GLA_DK))
    o = rms_norm(o, gla_norm_w).transpose(0, 2, 1, 3).reshape(b, s, GLA_VALUE_WIDTH).astype(h.dtype)
    gla_out = o * jax.nn.silu(r)
    return jnp.concatenate([pool_out, gla_out], axis=-1) @ w_out


def memory_cross_attention(h, mem_n, wq, wkv, wo):
    b, s, _ = h.shape
    m = mem_n.shape[1]
    q = (h @ wq).reshape(b, s, XATTN_HEADS, XATTN_HEAD_DIM)
    kv = mem_n @ wkv
    k = kv[..., :D_MODEL].reshape(b, m, XATTN_HEADS, XATTN_HEAD_DIM)
    v = kv[..., D_MODEL:].reshape(b, m, XATTN_HEADS, XATTN_HEAD_DIM)
    scores = jnp.einsum('bshd,bmhd->bhsm', q, k).astype(jnp.float32) * (XATTN_HEAD_DIM ** -0.5)
    probs = jax.nn.softmax(scores, axis=-1).astype(v.dtype)
    o = jnp.einsum('bhsm,bmhd->bshd', probs, v).reshape(b, s, D_MODEL)
    return o @ wo


def conv_ffn(h, w_up, conv_w, conv_b, w_down):
    s = h.shape[1]
    u = h @ w_up
    u_pad = jnp.pad(u, ((0, 0), (CONV_WIDTH - 1, 0), (0, 0)))
    u = conv_b + conv_w[0] * u_pad[:, 0:s] + conv_w[1] * u_pad[:, 1:1 + s] + conv_w[2] * u_pad[:, 2:2 + s]
    gate = u[..., :D_FF]
    val = u[..., D_FF:]
    return (jax.nn.silu(gate) * val) @ w_down


def setup_inputs(seed: int = 0) -> dict:
    key = jax.random.key(seed)
    ks = jax.random.split(key, 24)
    f32 = jnp.float32
    L = DEPTH

    def nrm(k, shape, scale):
        return jax.random.normal(k, shape, f32) * scale

    def gain(k, shape):
        return 1.0 + 0.05 * jax.random.normal(k, shape, f32)

    return {
        'x': jax.random.normal(ks[0], (BATCH, SEQ, D_MODEL), f32),
        'mem': jax.random.normal(ks[1], (BATCH, N_MEM, D_MODEL), f32),
        'norm_mix_w': gain(ks[2], (L, D_MODEL)),
        'w_in': nrm(ks[3], (L, D_MODEL, IN_PROJ_WIDTH), D_MODEL ** -0.5),
        'pool_w': nrm(ks[4], (L, POOL_GROUPS, POOL_GROUP_DIM, POOL_GROUP_DIM), POOL_GROUP_DIM ** -0.5),
        'pool_scale': 0.5 + 0.05 * jax.random.normal(ks[5], (L, POOL_WIDTH), f32),
        'gk_w2': nrm(ks[6], (L, GLA_GATE_RANK, GLA_KEY_WIDTH), GLA_GATE_RANK ** -0.5),
        'gk_b': nrm(ks[7], (L, GLA_KEY_WIDTH), 0.1),
        'gla_norm_w': gain(ks[8], (L, GLA_DV)),
        'w_out': nrm(ks[9], (L, MIX_WIDTH, D_MODEL), MIX_WIDTH ** -0.5),
        'norm_xattn_w': gain(ks[10], (L, D_MODEL)),
        'norm_mem_w': gain(ks[11], (L, D_MODEL)),
        'xattn_wq': nrm(ks[12], (L, D_MODEL, D_MODEL), D_MODEL ** -0.5),
        'xattn_wkv': nrm(ks[13], (L, D_MODEL, 2 * D_MODEL), D_MODEL ** -0.5),
        'xattn_wo': nrm(ks[14], (L, D_MODEL, D_MODEL), D_MODEL ** -0.5),
        'norm_ffn_w': gain(ks[15], (L, D_MODEL)),
        'ffn_w_up': nrm(ks[16], (L, D_MODEL, 2 * D_FF), D_MODEL ** -0.5),
        'ffn_conv_w': nrm(ks[17], (L, CONV_WIDTH, 2 * D_FF), CONV_WIDTH ** -0.5),
        'ffn_conv_b': nrm(ks[18], (L, 2 * D_FF), 0.01),
        'ffn_w_down': nrm(ks[19], (L, D_FF, D_MODEL), D_FF ** -0.5),
        'norm_final_w': gain(ks[20], (D_MODEL,)),
    }


def reference(x, mem, norm_mix_w, w_in, pool_w, pool_scale, gk_w2, gk_b, gla_norm_w, w_out,
              norm_xattn_w, norm_mem_w, xattn_wq, xattn_wkv, xattn_wo,
              norm_ffn_w, ffn_w_up, ffn_conv_w, ffn_conv_b, ffn_w_down, norm_final_w):
    for l in range(DEPTH):
        h = rms_norm(x, norm_mix_w[l])
        x = x + hybrid_mixer(h, w_in[l], pool_w[l], pool_scale[l], gk_w2[l], gk_b[l], gla_norm_w[l], w_out[l])
        h = rms_norm(x, norm_xattn_w[l])
        m = rms_norm(mem, norm_mem_w[l])
        x = x + memory_cross_attention(h, m, xattn_wq[l], xattn_wkv[l], xattn_wo[l])
        h = rms_norm(x, norm_ffn_w[l])
        x = x + conv_ffn(h, ffn_w_up[l], ffn_conv_w[l], ffn_conv_b[l], ffn_w_down[l])
    return rms_norm(x, norm_final_w)
```

```cpp
#include <hip/hip_runtime.h>
#include <cstdio>
#include <cstdint>

#define DI __device__ __forceinline__
#define LAS __attribute__((address_space(3)))
#define GAS __attribute__((address_space(1)))
typedef unsigned short bf16;
typedef short bf16x8 __attribute__((ext_vector_type(8)));
typedef float f32x4 __attribute__((ext_vector_type(4)));
typedef float f32x16 __attribute__((ext_vector_type(16)));
typedef unsigned u32x4 __attribute__((ext_vector_type(4)));
typedef unsigned u32x2 __attribute__((ext_vector_type(2)));
typedef float f32x2_t __attribute__((ext_vector_type(2)));
typedef __bf16 bf16x2_t __attribute__((ext_vector_type(2)));

#ifndef MK_SINGLE
#define MK_SINGLE 0
#endif

constexpr int NB = 32, SEQ = 2048, DM = 1024, T = NB * SEQ;
constexpr int NMEM = 256, TM = NB * NMEM;
constexpr int N1 = 2304;
constexpr int C_Y = 0, C_Q = 512, C_K = 768, C_V = 1024, C_LG = 1536, C_SR = 1792;
constexpr int WIN_LD = 2064;
constexpr int FF = 2816, NUP = 2 * FF;
constexpr float EPS = 1e-6f;
constexpr float LOG2E = 1.4426950408889634f;
constexpr int NPHASE = 13;

constexpr size_t MiB = 1u << 20;
constexpr size_t WS_CTL = 0, CTL_ZERO_BYTES = 1 * MiB;
constexpr size_t WS_SS = 1 * MiB;
constexpr size_t WS_W1T = 2 * MiB, WS_WOT = 7 * MiB, WS_WQT = 9 * MiB, WS_WKT = 11 * MiB, WS_WVT = 13 * MiB, WS_WXOT = 15 * MiB, WS_WUT = 17 * MiB, WS_WDT = 28 * MiB;
constexpr size_t WS_MN = 34 * MiB, WS_KB = 50 * MiB, WS_VT = 66 * MiB;
constexpr size_t WS_X1B = 82 * MiB;
constexpr size_t WS_MIX = 210 * MiB;
constexpr size_t WS_H1 = 338 * MiB;
constexpr size_t WS_PROJ = 466 * MiB;
constexpr size_t WS_ACT = 210 * MiB;
constexpr size_t WS_UH = 562 * MiB;
constexpr size_t WS_END = 914 * MiB;

namespace pg8 {
constexpr int BM = 256, BK = 64, HALF = 128, HTB = HALF * BK * 2, STAGE_BYTES = 8 * HTB, NXCD = 8, WGM = 8;
__host__ __device__ __forceinline__ int lds_byte(int r, int c) { const int st = (r >> 4) * 2 + (c >> 5), rr = r & 15, cc = c & 31, ob = rr * 64 + cc * 2; return st * 1024 + (ob ^ (((ob >> 9) & 1) << 5)); }
__host__ __device__ __forceinline__ void stage_rc(int b, int& R, int& C) { const int st = b / 1024, sb = b % 1024, swz = sb ^ (((sb >> 9) & 1) << 5); R = (st >> 1) * 16 + swz / 64; C = (st & 1) * 32 + (swz % 64) / 2; }
__host__ __device__ __forceinline__ int perm32(int rho) { const int n = rho >> 4, i = rho & 15; return 8 * (i >> 2) + 4 * n + (i & 3); }
struct Unit { int pm, pn; };
struct Gemm { const bf16* A; const bf16* Bt; int M, N, K; };
struct StaticOrder {
    int nM, nN, nwg, G, c;
    __host__ __device__ void init(int M, int N, int G_, int c_) { nM = M / BM; nN = N / BM; nwg = nM * nN; G = G_; c = c_; }
    __host__ __device__ bool next(int i, Unit& u) const {
        const long L = (long)i * G + c; if (L >= nwg) return false;
        int wgid = (int)L; { const int q = nwg / NXCD, r = nwg % NXCD, xcd = wgid % NXCD, off = wgid / NXCD; wgid = (xcd < r ? xcd * (q + 1) : r * (q + 1) + (xcd - r) * q) + off; }
        const int nig = WGM * nN, gid = wgid / nig, fm = gid * WGM, gsz = (nM - fm) < WGM ? (nM - fm) : WGM;
        u.pm = fm + ((wgid % nig) % gsz); u.pn = (wgid % nig) / gsz; return true;
    }
    __device__ __forceinline__ void a_ready(const Unit&) const {}
    __device__ __forceinline__ void done(const Unit&) const {}
};

DI unsigned cvtpk(float lo, float hi) { f32x2_t v = {lo, hi}; bf16x2_t b = __builtin_convertvector(v, bf16x2_t); return __builtin_bit_cast(unsigned, b); }
DI float bflo(unsigned w) { return __uint_as_float(w << 16); }
DI float bfhi(unsigned w) { return __uint_as_float(w & 0xffff0000u); }


struct EpiG1 {
    static constexpr bool PERM = true, AFTER_DRAIN = false;
    bf16* O; const float* gkb;
    DI void operator()(const f32x4 (&acc)[2][2][4][2], const Unit& u, int wr, int wc, int fr, int fq) const {
        const int row0 = u.pm * BM + wr * 64 + fr, col0 = u.pn * BM + wc * 32 + 8 * fq;
        const int mode = (u.pn == 6) ? 1 : (u.pn >= 7 ? 2 : 0);
        f32x4 bv[2][2];
#pragma unroll
        for (int bj = 0; bj < 2; ++bj)
#pragma unroll
            for (int n = 0; n < 2; ++n) bv[bj][n] = (mode == 1) ? *(const f32x4*)(gkb + (col0 - C_LG) + bj * HALF + 4 * n) : (f32x4){0.f, 0.f, 0.f, 0.f};
#pragma unroll
        for (int ai = 0; ai < 2; ++ai)
#pragma unroll
            for (int m = 0; m < 4; ++m) { bf16* rowp = O + (size_t)(row0 + ai * HALF + m * 16) * N1 + col0;
#pragma unroll
                for (int bj = 0; bj < 2; ++bj) { f32x4 v0 = acc[ai][bj][m][0], v1 = acc[ai][bj][m][1];
                    if (mode == 1) {
                        v0 = v0 + bv[bj][0]; v1 = v1 + bv[bj][1];
#pragma unroll
                        for (int j = 0; j < 4; ++j) {
                            { const float z = v0[j]; v0[j] = (fminf(z, 0.f) - __logf(1.f + __expf(-fabsf(z)))) * 0.0625f; }
                            { const float z = v1[j]; v1[j] = (fminf(z, 0.f) - __logf(1.f + __expf(-fabsf(z)))) * 0.0625f; } }
                    } else if (mode == 2) {
#pragma unroll
                        for (int j = 0; j < 4; ++j) {
                            { const float z = v0[j]; v0[j] = z * __builtin_amdgcn_rcpf(1.f + __expf(-z)); }
                            { const float z = v1[j]; v1[j] = z * __builtin_amdgcn_rcpf(1.f + __expf(-z)); } }
                    }
                    u32x4 w; w.x = cvtpk(v0[0], v0[1]); w.y = cvtpk(v0[2], v0[3]); w.z = cvtpk(v1[0], v1[1]); w.w = cvtpk(v1[2], v1[3]);
                    *(u32x4*)(rowp + bj * HALF) = w; } }
    }
};
template <bool ROWSCALE> struct EpiBf16 {
    static constexpr bool PERM = true, AFTER_DRAIN = false;
    bf16* O; int ldc; const float* ss; float cs;
    DI void operator()(const f32x4 (&acc)[2][2][4][2], const Unit& u, int wr, int wc, int fr, int fq) const {
        const int row0 = u.pm * BM + wr * 64 + fr, col0 = u.pn * BM + wc * 32 + 8 * fq;
#pragma unroll
        for (int ai = 0; ai < 2; ++ai)
#pragma unroll
            for (int m = 0; m < 4; ++m) { const int row = row0 + ai * HALF + m * 16; bf16* rowp = O + (size_t)row * ldc + col0;
                float sc = 1.f; if (ROWSCALE) sc = rsqrtf(ss[row] * (1.f / DM) + EPS) * cs;
#pragma unroll
                for (int bj = 0; bj < 2; ++bj) { const f32x4 v0 = acc[ai][bj][m][0] * sc, v1 = acc[ai][bj][m][1] * sc;
                    u32x4 w; w.x = cvtpk(v0[0], v0[1]); w.y = cvtpk(v0[2], v0[3]); w.z = cvtpk(v1[0], v1[1]); w.w = cvtpk(v1[2], v1[3]);
                    *(u32x4*)(rowp + bj * HALF) = w; } }
    }
};
template <bool RESF32> struct EpiRes {
    static constexpr bool PERM = true, AFTER_DRAIN = false;
    const void* res; bf16* O; float* ss;
    DI void operator()(const f32x4 (&acc)[2][2][4][2], const Unit& u, int wr, int wc, int fr, int fq) const {
        const int row0 = u.pm * BM + wr * 64 + fr, col0 = u.pn * BM + wc * 32 + 8 * fq;
#pragma unroll
        for (int ai = 0; ai < 2; ++ai)
#pragma unroll
            for (int m = 0; m < 4; ++m) { const int row = row0 + ai * HALF + m * 16; const size_t off = (size_t)row * DM + col0; float s = 0.f;
#pragma unroll
                for (int bj = 0; bj < 2; ++bj) { f32x4 r0, r1;
                    if (RESF32) { const float* rp = (const float*)res + off + bj * HALF; r0 = *(const f32x4*)rp; r1 = *(const f32x4*)(rp + 4); }
                    else { const u32x4 rw = *(const u32x4*)((const bf16*)res + off + bj * HALF); r0 = (f32x4){bflo(rw.x), bfhi(rw.x), bflo(rw.y), bfhi(rw.y)}; r1 = (f32x4){bflo(rw.z), bfhi(rw.z), bflo(rw.w), bfhi(rw.w)}; }
                    const f32x4 v0 = acc[ai][bj][m][0] + r0, v1 = acc[ai][bj][m][1] + r1;
                    s += (v0[0] * v0[0] + v0[1] * v0[1]) + (v0[2] * v0[2] + v0[3] * v0[3]) + (v1[0] * v1[0] + v1[1] * v1[1]) + (v1[2] * v1[2] + v1[3] * v1[3]);
                    u32x4 w; w.x = cvtpk(v0[0], v0[1]); w.y = cvtpk(v0[2], v0[3]); w.z = cvtpk(v1[0], v1[1]); w.w = cvtpk(v1[2], v1[3]);
                    *(u32x4*)(O + off + bj * HALF) = w; }
                s += __shfl_xor(s, 16); s += __shfl_xor(s, 32);
                if (fq == 0) atomicAdd(ss + row, s); }
    }
};
struct EpiOut {
    static constexpr bool PERM = true, AFTER_DRAIN = false;
    const bf16* res; float* O; float* ss;
    DI void operator()(const f32x4 (&acc)[2][2][4][2], const Unit& u, int wr, int wc, int fr, int fq) const {
        const int row0 = u.pm * BM + wr * 64 + fr, col0 = u.pn * BM + wc * 32 + 8 * fq;
#pragma unroll
        for (int ai = 0; ai < 2; ++ai)
#pragma unroll
            for (int m = 0; m < 4; ++m) { const int row = row0 + ai * HALF + m * 16; const size_t off = (size_t)row * DM + col0; float s = 0.f;
#pragma unroll
                for (int bj = 0; bj < 2; ++bj) {
                    const u32x4 rw = *(const u32x4*)(res + off + bj * HALF);
                    const f32x4 r0 = (f32x4){bflo(rw.x), bfhi(rw.x), bflo(rw.y), bfhi(rw.y)}, r1 = (f32x4){bflo(rw.z), bfhi(rw.z), bflo(rw.w), bfhi(rw.w)};
                    const f32x4 v0 = acc[ai][bj][m][0] + r0, v1 = acc[ai][bj][m][1] + r1;
                    s += (v0[0] * v0[0] + v0[1] * v0[1]) + (v0[2] * v0[2] + v0[3] * v0[3]) + (v1[0] * v1[0] + v1[1] * v1[1]) + (v1[2] * v1[2] + v1[3] * v1[3]);
                    *(f32x4*)(O + off + bj * HALF) = v0; *(f32x4*)(O + off + bj * HALF + 4) = v1; }
                s += __shfl_xor(s, 16); s += __shfl_xor(s, 32);
                if (fq == 0) atomicAdd(ss + row, s); }
    }
};

template <class Epi, class Sched, bool ALIGN_EPI = false, bool SP2 = false>
__device__ __forceinline__ void gemm_phase(LAS unsigned char* lds, const Gemm g, const Sched& S, const Epi& E) {
    const int tid = threadIdx.x, wid = __builtin_amdgcn_readfirstlane(tid >> 6), lane = tid & 63, wr = wid >> 2, wc = wid & 3, fr = lane & 15, fq = lane >> 4;
    const int K = g.K, nt = K / BK;
    unsigned voffA[2], voffB[2];
#pragma unroll
    for (int i = 0; i < 2; ++i) { int R, C; stage_rc(tid * 16 + i * 8192, R, C); const int Rb = Epi::PERM ? ((R & ~31) + perm32(R & 31)) : R;
        voffA[i] = (unsigned)(R * K + C) * 2u; voffB[i] = (unsigned)(Rb * K + C) * 2u; }
    const size_t kstep = (size_t)(BK * 2);
    const size_t hstep = (size_t)HALF * K * 2;
    const size_t tstep = 2 * hstep;
    const unsigned ldsw = (unsigned)wid * 1024u;
    const int aoff = lds_byte(wr * 64 + fr, fq * 8), boff = lds_byte(wc * 32 + fr, fq * 8);
#define PG8_SA(b, h) (((b) * 2 + (h)) * HTB)
#define PG8_SB(b, h) ((4 + (b) * 2 + (h)) * HTB)
#define PG8_STAGE(bufoff, gbase, voff) do { _Pragma("unroll") for (int _i = 0; _i < 2; ++_i) \
        __builtin_amdgcn_global_load_lds((const unsigned*)((const char*)(gbase) + (voff)[_i]), (LAS unsigned*)(lds + (bufoff) + ldsw + _i * 8192), 16, 0, 0); } while (0)
#define PG8_LDA(dst, b, h) do { _Pragma("unroll") for (int m = 0; m < 4; ++m) _Pragma("unroll") for (int k = 0; k < 2; ++k) dst[m][k] = *(const LAS bf16x8*)(lds + PG8_SA(b, h) + aoff + m * 2048 + k * 1024); } while (0)
#define PG8_LDB(dst, b, h) do { _Pragma("unroll") for (int n = 0; n < 2; ++n) _Pragma("unroll") for (int k = 0; k < 2; ++k) dst[n][k] = *(const LAS bf16x8*)(lds + PG8_SB(b, h) + boff + n * 2048 + k * 1024); } while (0)
#define PG8_MMA(ai, bj, At, Bt) do { __builtin_amdgcn_s_setprio(1); _Pragma("unroll") for (int m = 0; m < 4; ++m) _Pragma("unroll") for (int n = 0; n < 2; ++n) _Pragma("unroll") for (int k = 0; k < 2; ++k) \
        acc[ai][bj][m][n] = __builtin_amdgcn_mfma_f32_16x16x32_bf16(Bt[n][k], At[m][k], acc[ai][bj][m][n], 0, 0, 0); __builtin_amdgcn_s_setprio(0); } while (0)
#define PG8_WAIT_V(n) asm volatile("s_waitcnt vmcnt(" #n ")" ::: "memory")
#define PG8_WAIT_L(n) asm volatile("s_waitcnt lgkmcnt(" #n ")" ::: "memory")
#define PG8_BAR __builtin_amdgcn_s_barrier()
#define PG8_SCHED __builtin_amdgcn_sched_barrier(0)
    Unit cur, nxt; int ui = 0;
    if (!S.next(0, cur)) return;
    f32x4 acc[2][2][4][2];
#pragma unroll
    for (int a = 0; a < 2; ++a)
#pragma unroll
        for (int b = 0; b < 2; ++b)
#pragma unroll
            for (int m = 0; m < 4; ++m)
#pragma unroll
                for (int n = 0; n < 2; ++n) acc[a][b][m][n] = (f32x4){0.f, 0.f, 0.f, 0.f};
    bf16x8 At[4][2], B0[2][2], B1[2][2];
    const char* cA = (const char*)g.A + (size_t)cur.pm * tstep; const char* cB = (const char*)g.Bt + (size_t)cur.pn * tstep;
    S.a_ready(cur);
    if constexpr (SP2) {
        PG8_STAGE(PG8_SB(0, 0), cB, voffB); PG8_STAGE(PG8_SB(0, 1), cB + hstep, voffB); PG8_STAGE(PG8_SA(0, 0), cA, voffA); PG8_STAGE(PG8_SA(0, 1), cA + hstep, voffA);
        if (wr == 1) PG8_BAR;
        PG8_WAIT_V(2); PG8_BAR;
        PG8_STAGE(PG8_SB(1, 0), cB + kstep, voffB); PG8_STAGE(PG8_SA(1, 0), cA + kstep, voffA); PG8_STAGE(PG8_SB(1, 1), cB + hstep + kstep, voffB);
        PG8_WAIT_V(6); PG8_BAR;
    } else {
        PG8_STAGE(PG8_SB(0, 0), cB, voffB); PG8_STAGE(PG8_SA(0, 0), cA, voffA); PG8_STAGE(PG8_SB(0, 1), cB + hstep, voffB); PG8_STAGE(PG8_SA(0, 1), cA + hstep, voffA);
        if (wr == 1) PG8_BAR;
        PG8_WAIT_V(4); PG8_BAR;
        PG8_STAGE(PG8_SB(1, 0), cB + kstep, voffB); PG8_STAGE(PG8_SA(1, 0), cA + kstep, voffA); PG8_STAGE(PG8_SB(1, 1), cB + hstep + kstep, voffB);
        PG8_WAIT_V(6); PG8_BAR;
    }
    for (;;) {
        const bool has_next = S.next(ui + 1, nxt);
        const char* nA = has_next ? (const char*)g.A + (size_t)nxt.pm * tstep : cA; const char* nB = has_next ? (const char*)g.Bt + (size_t)nxt.pn * tstep : cB;
        for (int t = 0; t < nt; t += 2) {
            const bool last = (t == nt - 2);
            const char* a1 = cA + (size_t)(t + 1) * kstep;
            const char* a2 = last ? nA : cA + (size_t)(t + 2) * kstep; const char* b2 = last ? nB : cB + (size_t)(t + 2) * kstep;
            const char* a3 = a2 + kstep; const char* b3 = b2 + kstep;
            if (last && has_next) S.a_ready(nxt);
            if constexpr (SP2) {
            PG8_LDB(B0, 0, 0); PG8_LDB(B1, 0, 1); PG8_SCHED; PG8_LDA(At, 0, 0); PG8_STAGE(PG8_SA(1, 1), a1 + hstep, voffA);
            PG8_WAIT_V(8); PG8_WAIT_L(0); PG8_BAR; PG8_MMA(0, 0, At, B0); PG8_MMA(0, 1, At, B1); PG8_BAR; PG8_SCHED;
            PG8_LDA(At, 0, 1); PG8_STAGE(PG8_SB(0, 0), b2, voffB); PG8_STAGE(PG8_SB(0, 1), b2 + hstep, voffB); PG8_STAGE(PG8_SA(0, 0), a2, voffA);
            PG8_WAIT_V(8); PG8_WAIT_L(0); PG8_BAR; PG8_MMA(1, 0, At, B0); PG8_MMA(1, 1, At, B1); PG8_BAR; PG8_SCHED;
            PG8_LDB(B0, 1, 0); PG8_LDB(B1, 1, 1); PG8_SCHED; PG8_LDA(At, 1, 0); PG8_STAGE(PG8_SA(0, 1), a2 + hstep, voffA);
            PG8_WAIT_V(8); PG8_WAIT_L(0); PG8_BAR; PG8_MMA(0, 0, At, B0); PG8_MMA(0, 1, At, B1); PG8_BAR; PG8_SCHED;
            PG8_LDA(At, 1, 1); PG8_STAGE(PG8_SB(1, 0), b3, voffB); PG8_STAGE(PG8_SB(1, 1), b3 + hstep, voffB); PG8_STAGE(PG8_SA(1, 0), a3, voffA);
            PG8_WAIT_V(8); PG8_WAIT_L(0); PG8_BAR; PG8_MMA(1, 0, At, B0); PG8_MMA(1, 1, At, B1); PG8_BAR; PG8_SCHED;
            } else {
            PG8_LDB(B0, 0, 0); PG8_SCHED; PG8_LDA(At, 0, 0); PG8_STAGE(PG8_SA(1, 1), a1 + hstep, voffA);
            PG8_WAIT_L(8); PG8_BAR; PG8_WAIT_L(0); PG8_MMA(0, 0, At, B0); PG8_BAR; PG8_SCHED;
            PG8_LDB(B1, 0, 1); PG8_STAGE(PG8_SB(0, 0), b2, voffB);
            PG8_BAR; PG8_WAIT_L(0); PG8_MMA(0, 1, At, B1); PG8_BAR;
            PG8_LDA(At, 0, 1); PG8_STAGE(PG8_SA(0, 0), a2, voffA);
            PG8_BAR; PG8_WAIT_L(0); PG8_MMA(1, 0, At, B0); PG8_BAR; PG8_SCHED;
            PG8_STAGE(PG8_SB(0, 1), b2 + hstep, voffB);
            PG8_WAIT_V(6); PG8_BAR; PG8_MMA(1, 1, At, B1); PG8_BAR;
            PG8_LDB(B0, 1, 0); PG8_SCHED; PG8_LDA(At, 1, 0); PG8_STAGE(PG8_SA(0, 1), a2 + hstep, voffA);
            PG8_WAIT_L(8); PG8_BAR; PG8_WAIT_L(0); PG8_MMA(0, 0, At, B0); PG8_BAR; PG8_SCHED;
            PG8_LDB(B1, 1, 1); PG8_STAGE(PG8_SB(1, 0), b3, voffB);
            PG8_BAR; PG8_WAIT_L(0); PG8_MMA(0, 1, At, B1); PG8_BAR;
            PG8_LDA(At, 1, 1); PG8_STAGE(PG8_SA(1, 0), a3, voffA);
            PG8_BAR; PG8_WAIT_L(0); PG8_MMA(1, 0, At, B0); PG8_BAR; PG8_SCHED;
            PG8_STAGE(PG8_SB(1, 1), b3 + hstep, voffB);
            PG8_WAIT_V(6); PG8_BAR; PG8_MMA(1, 1, At, B1); PG8_BAR;
            }
        }
        if constexpr (ALIGN_EPI) { if (wr == 0) PG8_BAR; }
        if constexpr (!Epi::AFTER_DRAIN) { E(acc, cur, wr, wc, fr, fq); S.done(cur); }
        if (!has_next) break;
#pragma unroll
        for (int a = 0; a < 2; ++a)
#pragma unroll
            for (int b = 0; b < 2; ++b)
#pragma unroll
                for (int m = 0; m < 4; ++m)
#pragma unroll
                    for (int n = 0; n < 2; ++n) acc[a][b][m][n] = (f32x4){0.f, 0.f, 0.f, 0.f};
        cur = nxt; cA = nA; cB = nB; ++ui;
        if constexpr (ALIGN_EPI) { if (wr == 1) PG8_BAR; }
    }
    PG8_WAIT_V(0);
    if constexpr (!ALIGN_EPI) { if (wr == 0) PG8_BAR; }
    PG8_BAR;
#undef PG8_SA
#undef PG8_SB
#undef PG8_STAGE
#undef PG8_LDA
#undef PG8_LDB
#undef PG8_MMA
#undef PG8_WAIT_V
#undef PG8_WAIT_L
#undef PG8_BAR
#undef PG8_SCHED
}
}
using pg8::cvtpk; using pg8::bflo; using pg8::bfhi;

#ifndef PG8_SP2
#define PG8_SP2 true
#endif
#ifndef PG8_ALIGN
#define PG8_ALIGN true
#endif

constexpr int RING_OFF = 0, RING_BYTES = 131072;
constexpr int LDSCTL_OFF = RING_BYTES, MISC_OFF = LDSCTL_OFF + 320;
constexpr int LDS_BYTES = 147456;
constexpr int NWAVES = 8;

typedef GAS unsigned gu32;
#define RLX_AGENT __ATOMIC_RELAXED, __HIP_MEMORY_SCOPE_AGENT
#define LDS_WAIT() asm volatile("s_waitcnt lgkmcnt(0)" ::: "memory")
#define VM_WAIT() asm volatile("s_waitcnt vmcnt(0)" ::: "memory")
DI unsigned f2bf(float f) { unsigned u = __builtin_bit_cast(unsigned, f); return (u + 0x7fffu + ((u >> 16) & 1u)) >> 16; }
DI unsigned pk2(float lo, float hi) { return f2bf(lo) | (f2bf(hi) << 16); }
DI float bf2f(bf16 v) { return __uint_as_float(((unsigned)v) << 16); }
DI float fexp(float x) { return __builtin_amdgcn_exp2f(x * LOG2E); }

#define XB_TMO      128
#define XB_XCNT(j)  (256  + 64 * (j))
#define XB_XSUB(j)  (1280 + 64 * (j))
#define XB_XGEN(j)  (2304 + 64 * (j))
#define XB_TOP      3328
#define XB_TOPGEN   3392
#define XCD_BAR_WORDS 3456
#define XB_SPIN_CAP (1u << 18)
constexpr int CW_BAR = 4096;
DI unsigned xb_ld(unsigned* p)              { return __hip_atomic_load(p, __ATOMIC_RELAXED, __HIP_MEMORY_SCOPE_AGENT); }
DI unsigned xb_add(unsigned* p, unsigned v) { return __hip_atomic_fetch_add(p, v, __ATOMIC_RELAXED, __HIP_MEMORY_SCOPE_AGENT); }
DI unsigned xb_xcc_id() { return (unsigned)__builtin_amdgcn_s_getreg((3 << 11) | 20) & 0xFu; }
#define XB_SPIN(cond, bar) do { unsigned _sp = 0; while (cond) { __builtin_amdgcn_s_sleep(1); \
    if ((++_sp & 255u) == 0u) { if (xb_ld(&(bar)[XB_TMO])) break; if (_sp > XB_SPIN_CAP) { atomicAdd(&(bar)[XB_TMO], 1u); break; } } } } while (0)
struct XcdBarrier { unsigned* bar; unsigned x; volatile LAS unsigned* st; };
DI XcdBarrier xcd_barrier_post(unsigned* bar, volatile LAS unsigned* st) {
    XcdBarrier b; b.bar = bar; b.x = xb_xcc_id(); b.st = st;
    if (threadIdx.x == 0) (void)xb_add(&bar[XB_XCNT(b.x)], 1u);
    return b;
}
DI void xcd_barrier_complete(unsigned* bar, unsigned x, unsigned& nloc, unsigned& nx) {
    const unsigned G = gridDim.x * gridDim.y * gridDim.z;
    unsigned sum, cnt, mine, sp = 0u;
    for (;;) {
        sum = 0u; cnt = 0u; mine = 0u;
#pragma unroll
        for (unsigned j = 0; j < 16; ++j) { const unsigned c = xb_ld(&bar[XB_XCNT(j)]); sum += c; cnt += (c > 0u) ? 1u : 0u; mine = (j == x) ? c : mine; }
        if (sum == G) break;
        __builtin_amdgcn_s_sleep(1);
        if ((++sp & 255u) == 0u) { if (xb_ld(&bar[XB_TMO])) break; if (sp > XB_SPIN_CAP) { atomicAdd(&bar[XB_TMO], 1u); break; } }
    }
    nloc = mine > 0u ? mine : 1u; nx = cnt > 0u ? cnt : 1u;
}
DI void xcd_barrier(const XcdBarrier& b) {
    asm volatile("s_waitcnt vmcnt(0)" ::: "memory");
    __syncthreads();
    if (threadIdx.x == 0) {
        unsigned* bar = b.bar;
        __builtin_amdgcn_s_waitcnt(0);
        unsigned nloc = b.st[0], nx = b.st[1];
        if (nloc == 0u) { xcd_barrier_complete(bar, b.x, nloc, nx); b.st[0] = nloc; b.st[1] = nx; }
        const unsigned old = xb_add(&bar[XB_XSUB(b.x)], 1u);
        const unsigned gen = old / nloc;
        if (old + 1u == (gen + 1u) * nloc) {
            __builtin_amdgcn_fence(__ATOMIC_RELEASE, "agent");
            asm volatile("s_waitcnt vmcnt(0)" ::: "memory");
            const unsigned og = xb_add(&bar[XB_TOP], 1u);
            const unsigned tg = og / nx;
            if (og + 1u == (tg + 1u) * nx) xb_add(&bar[XB_TOPGEN], 1u);
            else XB_SPIN(xb_ld(&bar[XB_TOPGEN]) == tg, bar);
            __builtin_amdgcn_fence(__ATOMIC_ACQUIRE, "agent");
            xb_add(&bar[XB_XGEN(b.x)], 1u);
            asm volatile("s_waitcnt vmcnt(0)" ::: "memory");
        } else {
            XB_SPIN(xb_ld(&bar[XB_XGEN(b.x)]) == gen, bar);
            __builtin_amdgcn_fence(__ATOMIC_ACQUIRE, "agent");
            asm volatile("s_waitcnt vmcnt(0)" ::: "memory");
        }
    }
    __syncthreads();
}

struct Args { const float* in[21]; float* out; unsigned char* ws; int ph_lo, ph_hi; };
struct Frame {
    LAS unsigned char* lds;
    int tid, lane, wave, vcu, G;
    const float* in[21]; float* out; unsigned char* ws;
};
DI float wave_sum(float v) {
#pragma unroll
    for (int o = 1; o < 64; o <<= 1) v += __shfl_xor(v, o);
    return v;
}

template <class F> DI void wt_item(F val, int K, bf16* WT, int nblk, LAS float* scr, int item, int lane) {
    const int kb = item / nblk, nb = item % nblk, k0 = 64 * kb, n0 = 32 * nb;
#pragma unroll 4
    for (int i = 0; i < 32; ++i) { const int kk = 2 * i + (lane >> 5); scr[kk * 33 + (lane & 31)] = val(k0 + kk, n0 + (lane & 31)); }
    LDS_WAIT(); asm volatile("" ::: "memory");
    const int c = lane & 7;
#pragma unroll
    for (int j = 0; j < 4; ++j) { const int n = (lane >> 3) + 8 * j; const LAS float* s = scr + (8 * c) * 33 + n;
        u32x4 o; o.x = pk2(s[0 * 33], s[1 * 33]); o.y = pk2(s[2 * 33], s[3 * 33]); o.z = pk2(s[4 * 33], s[5 * 33]); o.w = pk2(s[6 * 33], s[7 * 33]);
        *(u32x4*)(WT + (size_t)(n0 + n) * K + k0 + 8 * c) = o; }
    LDS_WAIT(); asm volatile("" ::: "memory");
}
DI void norm_row_to_bf16(int lane, const float* xrow, const f32x4 (&w)[4], bf16* orow) {
    const f32x4* xr = (const f32x4*)xrow + lane;
    f32x4 v[4]; float s = 0.f;
#pragma unroll
    for (int j = 0; j < 4; ++j) { v[j] = xr[64 * j]; s += (v[j].x * v[j].x + v[j].y * v[j].y) + (v[j].z * v[j].z + v[j].w * v[j].w); }
    const float rstd = rsqrtf(wave_sum(s) * (1.f / DM) + EPS);
    u32x2* o8 = (u32x2*)orow + lane;
#pragma unroll
    for (int j = 0; j < 4; ++j) { u32x2 o; o.x = cvtpk(v[j].x * rstd * w[j].x, v[j].y * rstd * w[j].y); o.y = cvtpk(v[j].z * rstd * w[j].z, v[j].w * rstd * w[j].w); o8[64 * j] = o; }
}
DI void p0_prologue(Frame& F) {
    LAS float* scr = (LAS float*)(F.lds + RING_OFF + F.wave * 16384);
    const int gw = F.vcu * NWAVES + F.wave, NGW = F.G * NWAVES, lane = F.lane;
    const float* win = F.in[3]; const float* pw = F.in[4]; const float* ps = F.in[5]; const float* gw2 = F.in[6];
    const float* wout = F.in[9]; const float* nxw = F.in[10]; const float* wq = F.in[12]; const float* wkv = F.in[13]; const float* wxo = F.in[14];
    const float* nfw = F.in[15]; const float* wup = F.in[16]; const float* wdn = F.in[19];
    bf16* W1T = (bf16*)(F.ws + WS_W1T); bf16* WOT = (bf16*)(F.ws + WS_WOT); bf16* WQT = (bf16*)(F.ws + WS_WQT); bf16* WKT = (bf16*)(F.ws + WS_WKT);
    bf16* WVT = (bf16*)(F.ws + WS_WVT); bf16* WXOT = (bf16*)(F.ws + WS_WXOT); bf16* WUT = (bf16*)(F.ws + WS_WUT); bf16* WDT = (bf16*)(F.ws + WS_WDT);
    constexpr int I_Y = 16 * 16, I_QKV = 16 * 32, I_G = 16 * 8, I_R = 16 * 16, I_SQ = 16 * 32, I_UP = 16 * 176, I_DN = 44 * 32;
    constexpr int NITEMS = I_Y + I_QKV + I_G + I_R + 5 * I_SQ + I_UP + I_DN;
    for (int it = gw; it < NITEMS; it += NGW) {
        int r = it;
        if (r < I_Y) {
            wt_item([&](int k, int n) { const int g = n >> 7, d = n & 127; const float* a = win + (size_t)k * WIN_LD + g * 128; const float* b = pw + (size_t)g * 16384 + d; float s = 0.f;
#pragma unroll 8
                for (int c = 0; c < 128; ++c) s += a[c] * b[c * 128];
                return s * ps[n]; }, DM, W1T, 16, scr, r, lane); continue; } r -= I_Y;
        if (r < I_QKV) {
            wt_item([&](int k, int n) { const float v = win[(size_t)k * WIN_LD + 512 + n]; return n < 256 ? v * 0.125f : v; }, DM, W1T + (size_t)C_Q * DM, 32, scr, r, lane); continue; } r -= I_QKV;
        if (r < I_G) {
            wt_item([&](int k, int n) { const float* a = win + (size_t)k * WIN_LD + 1536; float s = 0.f;
#pragma unroll
                for (int c = 0; c < 16; ++c) s += a[c] * gw2[c * 256 + n];
                return s; }, DM, W1T + (size_t)C_LG * DM, 8, scr, r, lane); continue; } r -= I_G;
        if (r < I_R) { wt_item([&](int k, int n) { return win[(size_t)k * WIN_LD + 1552 + n]; }, DM, W1T + (size_t)C_SR * DM, 16, scr, r, lane); continue; } r -= I_R;
        if (r < I_SQ) { wt_item([&](int k, int n) { return wout[(size_t)k * DM + n]; }, DM, WOT, 32, scr, r, lane); continue; } r -= I_SQ;
        if (r < I_SQ) { wt_item([&](int k, int n) { return wq[(size_t)k * DM + n] * nxw[k]; }, DM, WQT, 32, scr, r, lane); continue; } r -= I_SQ;
        if (r < I_SQ) { wt_item([&](int k, int n) { return wkv[(size_t)k * 2048 + n]; }, DM, WKT, 32, scr, r, lane); continue; } r -= I_SQ;
        if (r < I_SQ) { wt_item([&](int k, int n) { return wkv[(size_t)k * 2048 + 1024 + n]; }, DM, WVT, 32, scr, r, lane); continue; } r -= I_SQ;
        if (r < I_SQ) { wt_item([&](int k, int n) { return wxo[(size_t)k * DM + n]; }, DM, WXOT, 32, scr, r, lane); continue; } r -= I_SQ;
        if (r < I_UP) {
            wt_item([&](int k, int n) { const int pn = n >> 8, bj = (n >> 7) & 1, j = n & 127; return wup[(size_t)k * NUP + bj * FF + pn * 128 + j] * nfw[k]; }, DM, WUT, 176, scr, r, lane); continue; } r -= I_UP;
        wt_item([&](int k, int n) { return wdn[(size_t)k * DM + n]; }, FF, WDT, 32, scr, r, lane);
    }
    { float* ss = (float*)(F.ws + WS_SS); for (int i = (F.vcu * 512 + F.tid); i < 3 * T; i += F.G * 512) ss[i] = 0.f; }
    { const float* w = F.in[2]; f32x4 wv[4];
#pragma unroll
      for (int j = 0; j < 4; ++j) wv[j] = ((const f32x4*)w)[lane + 64 * j];
      bf16* H1 = (bf16*)(F.ws + WS_H1);
      for (int m = gw; m < T; m += NGW) norm_row_to_bf16(lane, F.in[0] + (size_t)m * DM, wv, H1 + (size_t)m * DM); }
    { const float* w = F.in[11]; f32x4 wv[4];
#pragma unroll
      for (int j = 0; j < 4; ++j) wv[j] = ((const f32x4*)w)[lane + 64 * j];
      bf16* MN = (bf16*)(F.ws + WS_MN);
      for (int m = gw; m < TM; m += NGW) norm_row_to_bf16(lane, F.in[1] + (size_t)m * DM, wv, MN + (size_t)m * DM); }
}

DI int crow(int reg, int h) { return (reg & 3) + 8 * (reg >> 2) + 4 * h; }
#define MFMA32(a, b, c) __builtin_amdgcn_mfma_f32_32x32x16_bf16((a), (b), (c), 0, 0, 0)
constexpr int GP = 144;
DI void mma_tile(f32x16& acc, LAS const unsigned char* A, LAS const unsigned char* B, int ksteps, int lane) {
    const int r = lane & 31, h = lane >> 5;
    LAS const unsigned char* ap = A + r * GP + 16 * h; LAS const unsigned char* bp = B + r * GP + 16 * h;
    for (int ks = 0; ks < ksteps; ++ks) { const bf16x8 a = *(const LAS bf16x8*)(ap + 32 * ks), b = *(const LAS bf16x8*)(bp + 32 * ks); acc = MFMA32(a, b, acc); }
}
DI void gla_item(Frame& F, int b, int h) {
    LAS unsigned char* L = F.lds;
    constexpr int QD = 0, KD = QD + 64 * GP, KET = KD + 64 * GP, VTL = KET + 64 * GP, SC = VTL + 128 * GP, STL = SC + 64 * GP, OL = STL + 128 * GP, OLP = 528,
                  DEC = OL + 64 * OLP, TOT = DEC + 256, GEND = TOT + 2048;
    static_assert(GEND <= RING_BYTES, "GLA LDS");
    const int tid = F.tid, lane = F.lane, wave = F.wave, r = lane & 31, hh = lane >> 5;
    const bf16* proj = (const bf16*)(F.ws + WS_PROJ); bf16* mix = (bf16*)(F.ws + WS_MIX); const float* gnw = F.in[8];
    for (int i = tid; i < 128 * GP / 4; i += 512) ((LAS unsigned*)(L + STL))[i] = 0u;
    f32x16 accS;
#pragma unroll
    for (int i = 0; i < 16; ++i) accS[i] = 0.f;
    const int it_o = wave >> 2, et_o = wave & 3, et_s = wave >> 1, dt_s = wave & 1;
    __syncthreads();
    for (int n = 0; n < SEQ / 64; ++n) {
        const size_t tok0 = (size_t)b * SEQ + 64 * n;
        const bf16* base = proj + tok0 * N1;
        {
            const int d = tid & 63, tg = tid >> 6;
            float lgv[8], qv[8], kv[8];
#pragma unroll
            for (int ii = 0; ii < 8; ++ii) { const bf16* rp = base + (size_t)(8 * tg + ii) * N1 + 64 * h + d; lgv[ii] = bf2f(rp[C_LG]); qv[ii] = bf2f(rp[C_Q]); kv[ii] = bf2f(rp[C_K]); }
            {
                const int e = tid & 127, tq = tid >> 7; unsigned pkv[8];
#pragma unroll
                for (int jj = 0; jj < 8; ++jj) { const bf16* rp = base + (size_t)(16 * tq + 2 * jj) * N1 + C_V + 128 * h + e; pkv[jj] = (unsigned)rp[0] | ((unsigned)rp[N1] << 16); }
                LAS u32x4* dst = (LAS u32x4*)(L + VTL + e * GP + tq * 32);
                dst[0] = (u32x4){pkv[0], pkv[1], pkv[2], pkv[3]}; dst[1] = (u32x4){pkv[4], pkv[5], pkv[6], pkv[7]};
            }
#pragma unroll
            for (int ii = 1; ii < 8; ++ii) lgv[ii] += lgv[ii - 1];
            ((LAS float*)(L + TOT))[tg * 64 + d] = lgv[7];
            __syncthreads();
            float pre = 0.f, tot = 0.f;
#pragma unroll
            for (int g = 0; g < 8; ++g) { const float t = ((LAS float*)(L + TOT))[g * 64 + d]; tot += t; pre += (g < tg) ? t : 0.f; }
            unsigned kep[4];
#pragma unroll
            for (int ii = 0; ii < 8; ii += 2) {
                const float G0 = pre + lgv[ii], G1 = pre + lgv[ii + 1];
                const float q0 = qv[ii] * fexp(G0), q1 = qv[ii + 1] * fexp(G1);
                const float k0 = kv[ii] * fexp(-G0), k1 = kv[ii + 1] * fexp(-G1);
                const float e0 = kv[ii] * fexp(tot - G0), e1 = kv[ii + 1] * fexp(tot - G1);
                *(LAS bf16*)(L + QD + (8 * tg + ii) * GP + 2 * d) = (bf16)f2bf(q0); *(LAS bf16*)(L + QD + (8 * tg + ii + 1) * GP + 2 * d) = (bf16)f2bf(q1);
                *(LAS bf16*)(L + KD + (8 * tg + ii) * GP + 2 * d) = (bf16)f2bf(k0); *(LAS bf16*)(L + KD + (8 * tg + ii + 1) * GP + 2 * d) = (bf16)f2bf(k1);
                kep[ii >> 1] = cvtpk(e0, e1);
            }
            *(LAS u32x4*)(L + KET + d * GP + tg * 16) = (u32x4){kep[0], kep[1], kep[2], kep[3]};
            if (tg == 0) ((LAS float*)(L + DEC))[d] = fexp(tot);
        }
        __syncthreads();
        f32x16 acc_o;
#pragma unroll
        for (int i = 0; i < 16; ++i) acc_o[i] = 0.f;
        if (wave < 3) {
            const int it = (wave >= 1) ? 1 : 0, jt = (wave == 2) ? 1 : 0;
            f32x16 sc;
#pragma unroll
            for (int i = 0; i < 16; ++i) sc[i] = 0.f;
            mma_tile(sc, L + QD + it * 32 * GP, L + KD + jt * 32 * GP, 4, lane);
#pragma unroll
            for (int reg = 0; reg < 16; ++reg) { const int i = 32 * it + crow(reg, hh), j = 32 * jt + r; const float v = (j <= i) ? sc[reg] : 0.f; *(LAS bf16*)(L + SC + i * GP + 2 * j) = (bf16)f2bf(v); }
        }
        mma_tile(acc_o, L + QD + it_o * 32 * GP, L + STL + et_o * 32 * GP, 4, lane);
        { const float dec = ((LAS float*)(L + DEC))[32 * dt_s + r];
#pragma unroll
          for (int i = 0; i < 16; ++i) accS[i] *= dec;
          mma_tile(accS, L + VTL + et_s * 32 * GP, L + KET + dt_s * 32 * GP, 4, lane); }
        __syncthreads();
        mma_tile(acc_o, L + SC + it_o * 32 * GP, L + VTL + et_o * 32 * GP, 2 * (it_o + 1), lane);
#pragma unroll
        for (int reg = 0; reg < 16; ++reg) {
            *(LAS bf16*)(L + STL + (32 * et_s + crow(reg, hh)) * GP + 2 * (32 * dt_s + r)) = (bf16)f2bf(accS[reg]);
            *(LAS float*)(L + OL + (32 * it_o + crow(reg, hh)) * OLP + 4 * (32 * et_o + r)) = acc_o[reg];
        }
        __syncthreads();
        {
            const int i = tid >> 3, eg = tid & 7; float o[16]; float s = 0.f;
#pragma unroll
            for (int q = 0; q < 4; ++q) { const f32x4 v = *(LAS const f32x4*)(L + OL + i * OLP + 64 * eg + 16 * q); o[4 * q] = v[0]; o[4 * q + 1] = v[1]; o[4 * q + 2] = v[2]; o[4 * q + 3] = v[3]; s += (v[0] * v[0] + v[1] * v[1]) + (v[2] * v[2] + v[3] * v[3]); }
            s += __shfl_xor(s, 1); s += __shfl_xor(s, 2); s += __shfl_xor(s, 4);
            const float rstd = rsqrtf(s * (1.f / 128.f) + EPS);
            const bf16* srp = base + (size_t)i * N1 + C_SR + 128 * h + 16 * eg;
            const u32x4 s0 = *(const u32x4*)srp, s1 = *(const u32x4*)(srp + 8);
            const unsigned sw[8] = {s0.x, s0.y, s0.z, s0.w, s1.x, s1.y, s1.z, s1.w};
            unsigned ow[8];
#pragma unroll
            for (int q = 0; q < 8; ++q) { const float g0 = gnw[16 * eg + 2 * q], g1 = gnw[16 * eg + 2 * q + 1]; ow[q] = cvtpk(o[2 * q] * rstd * g0 * bflo(sw[q]), o[2 * q + 1] * rstd * g1 * bfhi(sw[q])); }
            bf16* op = mix + (tok0 + i) * DM + 512 + 128 * h + 16 * eg;
            *(u32x4*)op = (u32x4){ow[0], ow[1], ow[2], ow[3]}; *(u32x4*)(op + 8) = (u32x4){ow[4], ow[5], ow[6], ow[7]};
        }
    }
}
DI void pool_item(Frame& F, int item) {
    const int lane = F.lane, b = item >> 5, blk = item & 31, c0 = 8 * lane, w = 2 << (lane >> 4);
    const bf16* proj = (const bf16*)(F.ws + WS_PROJ); bf16* mix = (bf16*)(F.ws + WS_MIX);
    const size_t seq0 = (size_t)b * SEQ; const int p0 = 64 * blk;
    float s[8];
#pragma unroll
    for (int j = 0; j < 8; ++j) s[j] = 0.f;
    for (int k = 15; k >= 1; --k) { const int p = p0 - k; if (k <= w - 1 && p >= 0) { const u32x4 v = *(const u32x4*)(proj + (seq0 + p) * N1 + c0);
        s[0] += bflo(v.x); s[1] += bfhi(v.x); s[2] += bflo(v.y); s[3] += bfhi(v.y); s[4] += bflo(v.z); s[5] += bfhi(v.z); s[6] += bflo(v.w); s[7] += bfhi(v.w); } }
    for (int t = 0; t < 64; ++t) {
        const int p = p0 + t; const u32x4 v = *(const u32x4*)(proj + (seq0 + p) * N1 + c0);
        const float y[8] = {bflo(v.x), bfhi(v.x), bflo(v.y), bfhi(v.y), bflo(v.z), bfhi(v.z), bflo(v.w), bfhi(v.w)};
        const float inv = 1.f / (float)((p + 1) < w ? (p + 1) : w);
        float o[8];
#pragma unroll
        for (int j = 0; j < 8; ++j) { s[j] += y[j]; o[j] = s[j] * inv - y[j]; }
        *(u32x4*)(mix + (seq0 + p) * DM + c0) = (u32x4){cvtpk(o[0], o[1]), cvtpk(o[2], o[3]), cvtpk(o[4], o[5]), cvtpk(o[6], o[7])};
        const int pd = p - w + 1;
        if (pd >= 0) { const u32x4 u = *(const u32x4*)(proj + (seq0 + pd) * N1 + c0);
            s[0] -= bflo(u.x); s[1] -= bfhi(u.x); s[2] -= bflo(u.y); s[3] -= bfhi(u.y); s[4] -= bflo(u.z); s[5] -= bfhi(u.z); s[6] -= bflo(u.w); s[7] -= bfhi(u.w); }
    }
}

DI void attn_wave_unit(Frame& F, int unit) {
    const int lane = F.lane, r = lane & 31, hh = lane >> 5;
    const int qb = unit & 63, bh = unit >> 6, b = bh >> 2, h = bh & 3;
    const bf16* Q = (const bf16*)(F.ws + WS_H1); const bf16* KB = (const bf16*)(F.ws + WS_KB); const bf16* VT = (const bf16*)(F.ws + WS_VT); bf16* O = (bf16*)(F.ws + WS_MIX);
    const size_t t0 = (size_t)b * SEQ + 32 * qb;
    bf16x8 qf[16];
    { const bf16* qp = Q + (t0 + r) * DM + 256 * h + 8 * hh;
#pragma unroll
      for (int ks = 0; ks < 16; ++ks) qf[ks] = *(const bf16x8*)(qp + 16 * ks); }
    f32x16 sacc[8];
    const bf16* kp = KB + ((size_t)b * NMEM + r) * DM + 256 * h + 8 * hh;
#pragma unroll
    for (int kt = 0; kt < 8; ++kt) {
#pragma unroll
        for (int i = 0; i < 16; ++i) sacc[kt][i] = 0.f;
#pragma unroll
        for (int ks = 0; ks < 16; ++ks) { const bf16x8 kf = *(const bf16x8*)(kp + (size_t)(32 * kt) * DM + 16 * ks); sacc[kt] = MFMA32(kf, qf[ks], sacc[kt]); }
    }
    float mx = sacc[0][0];
#pragma unroll
    for (int kt = 0; kt < 8; ++kt)
#pragma unroll
        for (int i = 0; i < 16; ++i) mx = fmaxf(mx, sacc[kt][i]);
    mx = fmaxf(mx, __shfl_xor(mx, 32));
    float sum = 0.f;
#pragma unroll
    for (int kt = 0; kt < 8; ++kt)
#pragma unroll
        for (int i = 0; i < 16; ++i) { const float p = __builtin_amdgcn_exp2f(sacc[kt][i] - mx); sacc[kt][i] = p; sum += p; }
    sum += __shfl_xor(sum, 32);
    const float inv = 1.f / sum;
    bf16x8 pf[8][2];
#pragma unroll
    for (int kt = 0; kt < 8; ++kt)
#pragma unroll
        for (int s = 0; s < 2; ++s) { u32x4 p; p.x = cvtpk(sacc[kt][8 * s], sacc[kt][8 * s + 1]); p.y = cvtpk(sacc[kt][8 * s + 2], sacc[kt][8 * s + 3]); p.z = cvtpk(sacc[kt][8 * s + 4], sacc[kt][8 * s + 5]); p.w = cvtpk(sacc[kt][8 * s + 6], sacc[kt][8 * s + 7]);
            pf[kt][s] = __builtin_bit_cast(bf16x8, p); }
    const bf16* vp = VT + ((size_t)(256 * h) + r) * TM + (size_t)b * NMEM + 4 * hh;
    bf16* op = O + (t0 + r) * DM + 256 * h + 4 * hh;
#pragma unroll 1
    for (int dt = 0; dt < 8; ++dt) {
        f32x16 oacc;
#pragma unroll
        for (int i = 0; i < 16; ++i) oacc[i] = 0.f;
        const bf16* vrow = vp + (size_t)(32 * dt) * TM;
#pragma unroll
        for (int kt = 0; kt < 8; ++kt)
#pragma unroll
            for (int s = 0; s < 2; ++s) { const u32x2 lo = *(const u32x2*)(vrow + 32 * kt + 16 * s), hi = *(const u32x2*)(vrow + 32 * kt + 16 * s + 8);
                const bf16x8 vf = __builtin_bit_cast(bf16x8, (u32x4){lo.x, lo.y, hi.x, hi.y}); oacc = MFMA32(vf, pf[kt][s], oacc); }
#pragma unroll
        for (int g = 0; g < 4; ++g) { u32x2 w; w.x = cvtpk(oacc[4 * g] * inv, oacc[4 * g + 1] * inv); w.y = cvtpk(oacc[4 * g + 2] * inv, oacc[4 * g + 3] * inv); *(u32x2*)(op + 32 * dt + 8 * g) = w; }
    }
}

DI void conv_half(Frame& F, int half) {
    const bf16* U = (const bf16*)(F.ws + WS_UH); bf16* ACT = (bf16*)(F.ws + WS_ACT);
    const float* cw = F.in[17]; const float* cb = F.in[18];
    constexpr int RUN = 32, NCG = FF / 8, NITEM = (T / 2 / RUN) * NCG;
    for (int item = F.vcu * 512 + F.tid; item < NITEM; item += F.G * 512) {
        const int rr = item / NCG, cg = item - rr * NCG, ca = 8 * cg, pn = ca >> 7, j = ca & 127;
        const int ucol = 256 * pn + j;
        float wg[3][8], wv[3][8], bg[8], bv[8];
#pragma unroll
        for (int t = 0; t < 3; ++t)
#pragma unroll
            for (int q = 0; q < 8; ++q) { wg[t][q] = cw[t * NUP + ca + q]; wv[t][q] = cw[t * NUP + FF + ca + q]; }
#pragma unroll
        for (int q = 0; q < 8; ++q) { bg[q] = cb[ca + q]; bv[q] = cb[FF + ca + q]; }
        const int lr0 = rr * RUN;
        const int pos0 = (lr0 & (SEQ - 1));
        float g1[8], g2[8], v1[8], v2[8];
#pragma unroll
        for (int q = 0; q < 8; ++q) { g1[q] = g2[q] = v1[q] = v2[q] = 0.f; }
        if (pos0 >= 2) {
            const u32x4 a = *(const u32x4*)(U + (size_t)(lr0 - 2) * NUP + ucol), b = *(const u32x4*)(U + (size_t)(lr0 - 2) * NUP + ucol + 128);
            const u32x4 c = *(const u32x4*)(U + (size_t)(lr0 - 1) * NUP + ucol), d = *(const u32x4*)(U + (size_t)(lr0 - 1) * NUP + ucol + 128);
            const unsigned aw[4] = {a.x, a.y, a.z, a.w}, bw[4] = {b.x, b.y, b.z, b.w}, cw4[4] = {c.x, c.y, c.z, c.w}, dw[4] = {d.x, d.y, d.z, d.w};
#pragma unroll
            for (int q = 0; q < 4; ++q) { g2[2 * q] = bflo(aw[q]); g2[2 * q + 1] = bfhi(aw[q]); v2[2 * q] = bflo(bw[q]); v2[2 * q + 1] = bfhi(bw[q]);
                g1[2 * q] = bflo(cw4[q]); g1[2 * q + 1] = bfhi(cw4[q]); v1[2 * q] = bflo(dw[q]); v1[2 * q + 1] = bfhi(dw[q]); }
        }
        for (int t = 0; t < RUN; ++t) {
            const size_t lr = (size_t)(lr0 + t);
            const u32x4 a = *(const u32x4*)(U + lr * NUP + ucol), b = *(const u32x4*)(U + lr * NUP + ucol + 128);
            const unsigned aw[4] = {a.x, a.y, a.z, a.w}, bw[4] = {b.x, b.y, b.z, b.w};
            float g0[8], v0[8]; unsigned ow[4];
#pragma unroll
            for (int q = 0; q < 4; ++q) { g0[2 * q] = bflo(aw[q]); g0[2 * q + 1] = bfhi(aw[q]); v0[2 * q] = bflo(bw[q]); v0[2 * q + 1] = bfhi(bw[q]); }
            float o[8];
#pragma unroll
            for (int q = 0; q < 8; ++q) {
                const float gg = bg[q] + wg[0][q] * g2[q] + wg[1][q] * g1[q] + wg[2][q] * g0[q];
                const float vv = bv[q] + wv[0][q] * v2[q] + wv[1][q] * v1[q] + wv[2][q] * v0[q];
                o[q] = gg * __builtin_amdgcn_rcpf(1.f + __expf(-gg)) * vv;
                g2[q] = g1[q]; g1[q] = g0[q]; v2[q] = v1[q]; v1[q] = v0[q];
            }
#pragma unroll
            for (int q = 0; q < 4; ++q) ow[q] = cvtpk(o[2 * q], o[2 * q + 1]);
            *(u32x4*)(ACT + ((size_t)half * (T / 2) + lr) * FF + ca) = (u32x4){ow[0], ow[1], ow[2], ow[3]};
        }
    }
}

DI void final_norm(Frame& F) {
    const int gw = F.vcu * NWAVES + F.wave, NGW = F.G * NWAVES, lane = F.lane;
    const float* ss = (const float*)(F.ws + WS_SS) + 2 * T; const float* w = F.in[20];
    f32x4 wv[4];
#pragma unroll
    for (int j = 0; j < 4; ++j) wv[j] = ((const f32x4*)w)[lane + 64 * j];
    for (int m = gw; m < T; m += NGW) {
        const float rstd = rsqrtf(ss[m] * (1.f / DM) + EPS);
        f32x4* p = (f32x4*)(F.out + (size_t)m * DM) + lane;
#pragma unroll
        for (int j = 0; j < 4; ++j) { f32x4 v = p[64 * j]; v = v * rstd * wv[j]; p[64 * j] = v; }
    }
}

__global__ void __launch_bounds__(NWAVES * 64, 2) hymba_fwd(Args args) {
    extern __shared__ __attribute__((aligned(16))) unsigned char lds[];
    Frame F;
    F.lds = (LAS unsigned char*)lds;
    F.tid = threadIdx.x; F.lane = F.tid & 63; F.wave = __builtin_amdgcn_readfirstlane(F.tid >> 6);
    F.G = gridDim.x; { const int bx = blockIdx.x; F.vcu = (F.G % 8 == 0) ? (bx % 8) * (F.G / 8) + bx / 8 : bx; }
#pragma unroll
    for (int i = 0; i < 21; ++i) F.in[i] = args.in[i];
    F.out = args.out; F.ws = args.ws;
    volatile LAS unsigned* MISC = (volatile LAS unsigned*)(F.lds + MISC_OFF);
    for (int u = F.tid; u < (LDS_BYTES - LDSCTL_OFF) / 4; u += NWAVES * 64) ((LAS unsigned*)(F.lds + LDSCTL_OFF))[u] = 0u;
    __syncthreads();
    const int lo = args.ph_lo, hi = args.ph_hi;
    XcdBarrier bar; bar.bar = (unsigned*)(F.ws + WS_CTL) + CW_BAR; bar.x = 0; bar.st = nullptr;
    if (hi - lo > 1) bar = xcd_barrier_post((unsigned*)(F.ws + WS_CTL) + CW_BAR, MISC + 8);
#define IN(k) (lo <= (k) && (k) < hi)
#define SEAM(k) do { if (IN(k) && IN((k) + 1)) xcd_barrier(bar); } while (0)
    const int cid = (int)blockIdx.x;
    bf16* W1T = (bf16*)(F.ws + WS_W1T); bf16* WOT = (bf16*)(F.ws + WS_WOT); bf16* WQT = (bf16*)(F.ws + WS_WQT); bf16* WKT = (bf16*)(F.ws + WS_WKT);
    bf16* WVT = (bf16*)(F.ws + WS_WVT); bf16* WXOT = (bf16*)(F.ws + WS_WXOT); bf16* WUT = (bf16*)(F.ws + WS_WUT); bf16* WDT = (bf16*)(F.ws + WS_WDT);
    bf16* H1 = (bf16*)(F.ws + WS_H1); bf16* PROJ = (bf16*)(F.ws + WS_PROJ); bf16* MIX = (bf16*)(F.ws + WS_MIX); bf16* X1B = (bf16*)(F.ws + WS_X1B);
    bf16* MN = (bf16*)(F.ws + WS_MN); bf16* KB = (bf16*)(F.ws + WS_KB); bf16* VT = (bf16*)(F.ws + WS_VT); bf16* ACT = (bf16*)(F.ws + WS_ACT); bf16* UH = (bf16*)(F.ws + WS_UH);
    float* SS1 = (float*)(F.ws + WS_SS); float* SS2 = SS1 + T; float* SS3 = SS2 + T;

    if (IN(0)) { p0_prologue(F); } SEAM(0);
    if (IN(1)) {
        { pg8::Gemm g{H1, W1T, T, N1, DM}; pg8::StaticOrder S; S.init(T, N1, F.G, cid); pg8::EpiG1 E{PROJ, F.in[7]};
          pg8::gemm_phase<pg8::EpiG1, pg8::StaticOrder, PG8_ALIGN, PG8_SP2>(F.lds + RING_OFF, g, S, E); }
        { pg8::Gemm g{MN, WKT, TM, DM, DM}; pg8::StaticOrder S; S.init(TM, DM, F.G, cid); pg8::EpiBf16<false> E{KB, DM, nullptr, 1.f};
          pg8::gemm_phase<pg8::EpiBf16<false>, pg8::StaticOrder, PG8_ALIGN, PG8_SP2>(F.lds + RING_OFF, g, S, E); }
        { pg8::Gemm g{WVT, MN, DM, TM, DM}; pg8::StaticOrder S; S.init(DM, TM, F.G, (cid + F.G / 2) % F.G); pg8::EpiBf16<false> E{VT, TM, nullptr, 1.f};
          pg8::gemm_phase<pg8::EpiBf16<false>, pg8::StaticOrder, PG8_ALIGN, PG8_SP2>(F.lds + RING_OFF, g, S, E); }
    } SEAM(1);
    if (IN(2)) {
        if (cid < 128) gla_item(F, cid >> 2, cid & 3);
        else { for (int item = (cid - 128) * NWAVES + F.wave; item < NB * (SEQ / 64); item += (F.G - 128) * NWAVES) pool_item(F, item); }
    } SEAM(2);
    if (IN(3)) { pg8::Gemm g{MIX, WOT, T, DM, DM}; pg8::StaticOrder S; S.init(T, DM, F.G, cid); pg8::EpiRes<true> E{F.in[0], X1B, SS1};
        pg8::gemm_phase<pg8::EpiRes<true>, pg8::StaticOrder, PG8_ALIGN, PG8_SP2>(F.lds + RING_OFF, g, S, E); } SEAM(3);
    if (IN(4)) { pg8::Gemm g{X1B, WQT, T, DM, DM}; pg8::StaticOrder S; S.init(T, DM, F.G, cid); pg8::EpiBf16<true> E{H1, DM, SS1, 0.0625f * LOG2E};
        pg8::gemm_phase<pg8::EpiBf16<true>, pg8::StaticOrder, PG8_ALIGN, PG8_SP2>(F.lds + RING_OFF, g, S, E); } SEAM(4);
    if (IN(5)) { for (int unit = cid * NWAVES + F.wave; unit < NB * 4 * (SEQ / 32); unit += F.G * NWAVES) attn_wave_unit(F, unit); } SEAM(5);
    if (IN(6)) { pg8::Gemm g{MIX, WXOT, T, DM, DM}; pg8::StaticOrder S; S.init(T, DM, F.G, cid); pg8::EpiRes<false> E{X1B, X1B, SS2};
        pg8::gemm_phase<pg8::EpiRes<false>, pg8::StaticOrder, PG8_ALIGN, PG8_SP2>(F.lds + RING_OFF, g, S, E); } SEAM(6);
#pragma unroll 1
    for (int half = 0; half < 2; ++half) {
        if (IN(7 + 2 * half)) { pg8::Gemm g{X1B + (size_t)half * (T / 2) * DM, WUT, T / 2, NUP, DM}; pg8::StaticOrder S; S.init(T / 2, NUP, F.G, cid);
            pg8::EpiBf16<true> E{UH, NUP, SS2 + half * (T / 2), 1.f};
            pg8::gemm_phase<pg8::EpiBf16<true>, pg8::StaticOrder, PG8_ALIGN, PG8_SP2>(F.lds + RING_OFF, g, S, E); } SEAM(7 + 2 * half);
        if (IN(8 + 2 * half)) { conv_half(F, half); } SEAM(8 + 2 * half);
    }
    if (IN(11)) { pg8::Gemm g{ACT, WDT, T, DM, FF}; pg8::StaticOrder S; S.init(T, DM, F.G, cid); pg8::EpiOut E{X1B, F.out, SS3};
        pg8::gemm_phase<pg8::EpiOut, pg8::StaticOrder, PG8_ALIGN, PG8_SP2>(F.lds + RING_OFF, g, S, E); } SEAM(11);
    if (IN(12)) { final_norm(F); }
#undef IN
#undef SEAM
}

extern "C" void kernel_launch(void* const* d_in, const int* in_sizes, int n_in, void* d_out, int out_size, void* d_ws, size_t ws_size, hipStream_t stream) {
    static int grid = 0;
    if (grid == 0) {
        if (n_in != 21 || in_sizes[0] != T * DM || out_size != T * DM || ws_size < WS_END) { fprintf(stderr, "kernel_launch: unexpected shapes (n_in %d, in0 %d, out %d, ws %zu)\n", n_in, n_in > 0 ? in_sizes[0] : -1, out_size, ws_size); grid = -1; return; }
        int dev = 0, cus = 0;
        if (hipGetDevice(&dev) != hipSuccess || hipDeviceGetAttribute(&cus, hipDeviceAttributeMultiprocessorCount, dev) != hipSuccess) { grid = -1; return; }
        if (hipFuncSetAttribute((const void*)hymba_fwd, hipFuncAttributeMaxDynamicSharedMemorySize, LDS_BYTES) != hipSuccess) { fprintf(stderr, "kernel_launch: hipFuncSetAttribute failed\n"); grid = -1; return; }
        (void)hipGetLastError();
        grid = 256; if (cus != 256) fprintf(stderr, "kernel_launch: device reports %d CUs; built for 256\n", cus);
    }
    if (grid < 0) return;
    hipMemsetAsync((char*)d_ws + WS_CTL, 0, CTL_ZERO_BYTES, stream);
    Args a{};
    for (int i = 0; i < 21; ++i) a.in[i] = (const float*)d_in[i];
    a.out = (float*)d_out; a.ws = (unsigned char*)d_ws;
#if MK_SINGLE
    a.ph_lo = 0; a.ph_hi = NPHASE;
    hipLaunchKernelGGL(hymba_fwd, dim3(grid), dim3(NWAVES * 64), LDS_BYTES, stream, a);
#else
    for (int p = 0; p < NPHASE; ++p) { a.ph_lo = p; a.ph_hi = p + 1; hipLaunchKernelGGL(hymba_fwd, dim3(grid), dim3(NWAVES * 64), LDS_BYTES, stream, a); }
#endif
}
```

```cpp
#include <hip/hip_runtime.h>
#include <cstdio>
#include <cstdint>

#define DI __device__ __forceinline__
#define LAS __attribute__((address_space(3)))
#define GAS __attribute__((address_space(1)))
typedef unsigned short bf16;
typedef short bf16x8 __attribute__((ext_vector_type(8)));
typedef float f32x4 __attribute__((ext_vector_type(4)));
typedef float f32x16 __attribute__((ext_vector_type(16)));
typedef unsigned u32x4 __attribute__((ext_vector_type(4)));
typedef unsigned u32x2 __attribute__((ext_vector_type(2)));
typedef float f32x2_t __attribute__((ext_vector_type(2)));
typedef __bf16 bf16x2_t __attribute__((ext_vector_type(2)));

#ifndef MK_SINGLE
#define MK_SINGLE 1
#endif

constexpr int NB = 32, SEQ = 2048, DM = 1024, T = NB * SEQ;
constexpr int NMEM = 256, TM = NB * NMEM;
constexpr int N1 = 2304;
constexpr int C_Y = 0, C_Q = 512, C_K = 768, C_V = 1024, C_LG = 1536, C_SR = 1792;
constexpr int WIN_LD = 2064;
constexpr int FF = 2816, NUP = 2 * FF;
constexpr float EPS = 1e-6f;
constexpr float LOG2E = 1.4426950408889634f;
constexpr int NPHASE = 13;

constexpr size_t MiB = 1u << 20;
constexpr size_t WS_CTL = 0, CTL_ZERO_BYTES = 1 * MiB;
constexpr size_t WS_SS = 1 * MiB;
constexpr size_t WS_W1T = 2 * MiB, WS_WOT = 7 * MiB, WS_WQT = 9 * MiB, WS_WKT = 11 * MiB, WS_WVT = 13 * MiB, WS_WXOT = 15 * MiB, WS_WUT = 17 * MiB, WS_WDT = 28 * MiB;
constexpr size_t WS_MN = 34 * MiB, WS_KB = 50 * MiB, WS_VT = 66 * MiB;
constexpr size_t WS_X1B = 82 * MiB;
constexpr size_t WS_MIX = 210 * MiB;
constexpr size_t WS_H1 = 338 * MiB;
constexpr size_t WS_PROJ = 466 * MiB;
constexpr size_t WS_ACT = 210 * MiB;
constexpr size_t WS_UH = 562 * MiB;
constexpr size_t WS_END = 914 * MiB;

namespace pg8 {
constexpr int BM = 256, BK = 64, HALF = 128, HTB = HALF * BK * 2, STAGE_BYTES = 8 * HTB, NXCD = 8, WGM = 8;
__host__ __device__ __forceinline__ int lds_byte(int r, int c) { const int st = (r >> 4) * 2 + (c >> 5), rr = r & 15, cc = c & 31, ob = rr * 64 + cc * 2; return st * 1024 + (ob ^ (((ob >> 9) & 1) << 5)); }
__host__ __device__ __forceinline__ void stage_rc(int b, int& R, int& C) { const int st = b / 1024, sb = b % 1024, swz = sb ^ (((sb >> 9) & 1) << 5); R = (st >> 1) * 16 + swz / 64; C = (st & 1) * 32 + (swz % 64) / 2; }
__host__ __device__ __forceinline__ int perm32(int rho) { const int n = rho >> 4, i = rho & 15; return 8 * (i >> 2) + 4 * n + (i & 3); }
struct Unit { int pm, pn; };
struct Gemm { const bf16* A; const bf16* Bt; int M, N, K; };
struct StaticOrder {
    int nM, nN, nwg, G, c;
    __host__ __device__ void init(int M, int N, int G_, int c_) { nM = M / BM; nN = N / BM; nwg = nM * nN; G = G_; c = c_; }
    __host__ __device__ bool next(int i, Unit& u) const {
        const long L = (long)i * G + c; if (L >= nwg) return false;
        int wgid = (int)L; { const int q = nwg / NXCD, r = nwg % NXCD, xcd = wgid % NXCD, off = wgid / NXCD; wgid = (xcd < r ? xcd * (q + 1) : r * (q + 1) + (xcd - r) * q) + off; }
        const int nig = WGM * nN, gid = wgid / nig, fm = gid * WGM, gsz = (nM - fm) < WGM ? (nM - fm) : WGM;
        u.pm = fm + ((wgid % nig) % gsz); u.pn = (wgid % nig) / gsz; return true;
    }
    __device__ __forceinline__ void a_ready(const Unit&) const {}
    __device__ __forceinline__ void done(const Unit&) const {}
};

DI unsigned cvtpk(float lo, float hi) { f32x2_t v = {lo, hi}; bf16x2_t b = __builtin_convertvector(v, bf16x2_t); return __builtin_bit_cast(unsigned, b); }
DI float bflo(unsigned w) { return __uint_as_float(w << 16); }
DI float bfhi(unsigned w) { return __uint_as_float(w & 0xffff0000u); }


struct EpiG1 {
    static constexpr bool PERM = true, AFTER_DRAIN = false;
    bf16* O; const float* gkb;
    DI void operator()(const f32x4 (&acc)[2][2][4][2], const Unit& u, int wr, int wc, int fr, int fq) const {
        const int row0 = u.pm * BM + wr * 64 + fr, col0 = u.pn * BM + wc * 32 + 8 * fq;
        const int mode = (u.pn == 6) ? 1 : (u.pn >= 7 ? 2 : 0);
        f32x4 bv[2][2];
#pragma unroll
        for (int bj = 0; bj < 2; ++bj)
#pragma unroll
            for (int n = 0; n < 2; ++n) bv[bj][n] = (mode == 1) ? *(const f32x4*)(gkb + (col0 - C_LG) + bj * HALF + 4 * n) : (f32x4){0.f, 0.f, 0.f, 0.f};
#pragma unroll
        for (int ai = 0; ai < 2; ++ai)
#pragma unroll
            for (int m = 0; m < 4; ++m) { bf16* rowp = O + (size_t)(row0 + ai * HALF + m * 16) * N1 + col0;
#pragma unroll
                for (int bj = 0; bj < 2; ++bj) { f32x4 v0 = acc[ai][bj][m][0], v1 = acc[ai][bj][m][1];
                    if (mode == 1) {
                        v0 = v0 + bv[bj][0]; v1 = v1 + bv[bj][1];
#pragma unroll
                        for (int j = 0; j < 4; ++j) {
                            { const float z = v0[j]; v0[j] = (fminf(z, 0.f) - __logf(1.f + __expf(-fabsf(z)))) * 0.0625f; }
                            { const float z = v1[j]; v1[j] = (fminf(z, 0.f) - __logf(1.f + __expf(-fabsf(z)))) * 0.0625f; } }
                    } else if (mode == 2) {
#pragma unroll
                        for (int j = 0; j < 4; ++j) {
                            { const float z = v0[j]; v0[j] = z * __builtin_amdgcn_rcpf(1.f + __expf(-z)); }
                            { const float z = v1[j]; v1[j] = z * __builtin_amdgcn_rcpf(1.f + __expf(-z)); } }
                    }
                    u32x4 w; w.x = cvtpk(v0[0], v0[1]); w.y = cvtpk(v0[2], v0[3]); w.z = cvtpk(v1[0], v1[1]); w.w = cvtpk(v1[2], v1[3]);
                    *(u32x4*)(rowp + bj * HALF) = w; } }
    }
};
template <bool ROWSCALE> struct EpiBf16 {
    static constexpr bool PERM = true, AFTER_DRAIN = false;
    bf16* O; int ldc; const float* ss; float cs;
    DI void operator()(const f32x4 (&acc)[2][2][4][2], const Unit& u, int wr, int wc, int fr, int fq) const {
        const int row0 = u.pm * BM + wr * 64 + fr, col0 = u.pn * BM + wc * 32 + 8 * fq;
#pragma unroll
        for (int ai = 0; ai < 2; ++ai)
#pragma unroll
            for (int m = 0; m < 4; ++m) { const int row = row0 + ai * HALF + m * 16; bf16* rowp = O + (size_t)row * ldc + col0;
                float sc = 1.f; if (ROWSCALE) sc = rsqrtf(ss[row] * (1.f / DM) + EPS) * cs;
#pragma unroll
                for (int bj = 0; bj < 2; ++bj) { const f32x4 v0 = acc[ai][bj][m][0] * sc, v1 = acc[ai][bj][m][1] * sc;
                    u32x4 w; w.x = cvtpk(v0[0], v0[1]); w.y = cvtpk(v0[2], v0[3]); w.z = cvtpk(v1[0], v1[1]); w.w = cvtpk(v1[2], v1[3]);
                    *(u32x4*)(rowp + bj * HALF) = w; } }
    }
};
template <bool RESF32> struct EpiRes {
    static constexpr bool PERM = true, AFTER_DRAIN = false;
    const void* res; bf16* O; float* ss;
    DI void operator()(const f32x4 (&acc)[2][2][4][2], const Unit& u, int wr, int wc, int fr, int fq) const {
        const int row0 = u.pm * BM + wr * 64 + fr, col0 = u.pn * BM + wc * 32 + 8 * fq;
#pragma unroll
        for (int ai = 0; ai < 2; ++ai)
#pragma unroll
            for (int m = 0; m < 4; ++m) { const int row = row0 + ai * HALF + m * 16; const size_t off = (size_t)row * DM + col0; float s = 0.f;
#pragma unroll
                for (int bj = 0; bj < 2; ++bj) { f32x4 r0, r1;
                    if (RESF32) { const float* rp = (const float*)res + off + bj * HALF; r0 = *(const f32x4*)rp; r1 = *(const f32x4*)(rp + 4); }
                    else { const u32x4 rw = *(const u32x4*)((const bf16*)res + off + bj * HALF); r0 = (f32x4){bflo(rw.x), bfhi(rw.x), bflo(rw.y), bfhi(rw.y)}; r1 = (f32x4){bflo(rw.z), bfhi(rw.z), bflo(rw.w), bfhi(rw.w)}; }
                    const f32x4 v0 = acc[ai][bj][m][0] + r0, v1 = acc[ai][bj][m][1] + r1;
                    s += (v0[0] * v0[0] + v0[1] * v0[1]) + (v0[2] * v0[2] + v0[3] * v0[3]) + (v1[0] * v1[0] + v1[1] * v1[1]) + (v1[2] * v1[2] + v1[3] * v1[3]);
                    u32x4 w; w.x = cvtpk(v0[0], v0[1]); w.y = cvtpk(v0[2], v0[3]); w.z = cvtpk(v1[0], v1[1]); w.w = cvtpk(v1[2], v1[3]);
                    *(u32x4*)(O + off + bj * HALF) = w; }
                s += __shfl_xor(s, 16); s += __shfl_xor(s, 32);
                if (fq == 0) atomicAdd(ss + row, s); }
    }
};
struct EpiOut {
    static constexpr bool PERM = true, AFTER_DRAIN = false;
    const bf16* res; float* O; float* ss;
    DI void operator()(const f32x4 (&acc)[2][2][4][2], const Unit& u, int wr, int wc, int fr, int fq) const {
        const int row0 = u.pm * BM + wr * 64 + fr, col0 = u.pn * BM + wc * 32 + 8 * fq;
#pragma unroll
        for (int ai = 0; ai < 2; ++ai)
#pragma unroll
            for (int m = 0; m < 4; ++m) { const int row = row0 + ai * HALF + m * 16; const size_t off = (size_t)row * DM + col0; float s = 0.f;
#pragma unroll
                for (int bj = 0; bj < 2; ++bj) {
                    const u32x4 rw = *(const u32x4*)(res + off + bj * HALF);
                    const f32x4 r0 = (f32x4){bflo(rw.x), bfhi(rw.x), bflo(rw.y), bfhi(rw.y)}, r1 = (f32x4){bflo(rw.z), bfhi(rw.z), bflo(rw.w), bfhi(rw.w)};
                    const f32x4 v0 = acc[ai][bj][m][0] + r0, v1 = acc[ai][bj][m][1] + r1;
                    s += (v0[0] * v0[0] + v0[1] * v0[1]) + (v0[2] * v0[2] + v0[3] * v0[3]) + (v1[0] * v1[0] + v1[1] * v1[1]) + (v1[2] * v1[2] + v1[3] * v1[3]);
                    *(f32x4*)(O + off + bj * HALF) = v0; *(f32x4*)(O + off + bj * HALF + 4) = v1; }
                s += __shfl_xor(s, 16); s += __shfl_xor(s, 32);
                if (fq == 0) atomicAdd(ss + row, s); }
    }
};

template <class Epi, class Sched, bool ALIGN_EPI = false, bool SP2 = false>
__device__ __forceinline__ void gemm_phase(LAS unsigned char* lds, const Gemm g, const Sched& S, const Epi& E) {
    const int tid = threadIdx.x, wid = __builtin_amdgcn_readfirstlane(tid >> 6), lane = tid & 63, wr = wid >> 2, wc = wid & 3, fr = lane & 15, fq = lane >> 4;
    const int K = g.K, nt = K / BK;
    unsigned voffA[2], voffB[2];
#pragma unroll
    for (int i = 0; i < 2; ++i) { int R, C; stage_rc(tid * 16 + i * 8192, R, C); const int Rb = Epi::PERM ? ((R & ~31) + perm32(R & 31)) : R;
        voffA[i] = (unsigned)(R * K + C) * 2u; voffB[i] = (unsigned)(Rb * K + C) * 2u; }
    const size_t kstep = (size_t)(BK * 2);
    const size_t hstep = (size_t)HALF * K * 2;
    const size_t tstep = 2 * hstep;
    const unsigned ldsw = (unsigned)wid * 1024u;
    const int aoff = lds_byte(wr * 64 + fr, fq * 8), boff = lds_byte(wc * 32 + fr, fq * 8);
#define PG8_SA(b, h) (((b) * 2 + (h)) * HTB)
#define PG8_SB(b, h) ((4 + (b) * 2 + (h)) * HTB)
#define PG8_STAGE(bufoff, gbase, voff) do { _Pragma("unroll") for (int _i = 0; _i < 2; ++_i) \
        __builtin_amdgcn_global_load_lds((const unsigned*)((const char*)(gbase) + (voff)[_i]), (LAS unsigned*)(lds + (bufoff) + ldsw + _i * 8192), 16, 0, 0); } while (0)
#define PG8_LDA(dst, b, h) do { _Pragma("unroll") for (int m = 0; m < 4; ++m) _Pragma("unroll") for (int k = 0; k < 2; ++k) dst[m][k] = *(const LAS bf16x8*)(lds + PG8_SA(b, h) + aoff + m * 2048 + k * 1024); } while (0)
#define PG8_LDB(dst, b, h) do { _Pragma("unroll") for (int n = 0; n < 2; ++n) _Pragma("unroll") for (int k = 0; k < 2; ++k) dst[n][k] = *(const LAS bf16x8*)(lds + PG8_SB(b, h) + boff + n * 2048 + k * 1024); } while (0)
#define PG8_MMA(ai, bj, At, Bt) do { __builtin_amdgcn_s_setprio(1); _Pragma("unroll") for (int m = 0; m < 4; ++m) _Pragma("unroll") for (int n = 0; n < 2; ++n) _Pragma("unroll") for (int k = 0; k < 2; ++k) \
        acc[ai][bj][m][n] = __builtin_amdgcn_mfma_f32_16x16x32_bf16(Bt[n][k], At[m][k], acc[ai][bj][m][n], 0, 0, 0); __builtin_amdgcn_s_setprio(0); } while (0)
#define PG8_WAIT_V(n) asm volatile("s_waitcnt vmcnt(" #n ")" ::: "memory")
#define PG8_WAIT_L(n) asm volatile("s_waitcnt lgkmcnt(" #n ")" ::: "memory")
#define PG8_BAR __builtin_amdgcn_s_barrier()
#define PG8_SCHED __builtin_amdgcn_sched_barrier(0)
    Unit cur, nxt; int ui = 0;
    if (!S.next(0, cur)) return;
    f32x4 acc[2][2][4][2];
#pragma unroll
    for (int a = 0; a < 2; ++a)
#pragma unroll
        for (int b = 0; b < 2; ++b)
#pragma unroll
            for (int m = 0; m < 4; ++m)
#pragma unroll
                for (int n = 0; n < 2; ++n) acc[a][b][m][n] = (f32x4){0.f, 0.f, 0.f, 0.f};
    bf16x8 At[4][2], B0[2][2], B1[2][2];
    const char* cA = (const char*)g.A + (size_t)cur.pm * tstep; const char* cB = (const char*)g.Bt + (size_t)cur.pn * tstep;
    S.a_ready(cur);
    if constexpr (SP2) {
        PG8_STAGE(PG8_SB(0, 0), cB, voffB); PG8_STAGE(PG8_SB(0, 1), cB + hstep, voffB); PG8_STAGE(PG8_SA(0, 0), cA, voffA); PG8_STAGE(PG8_SA(0, 1), cA + hstep, voffA);
        if (wr == 1) PG8_BAR;
        PG8_WAIT_V(2); PG8_BAR;
        PG8_STAGE(PG8_SB(1, 0), cB + kstep, voffB); PG8_STAGE(PG8_SA(1, 0), cA + kstep, voffA); PG8_STAGE(PG8_SB(1, 1), cB + hstep + kstep, voffB);
        PG8_WAIT_V(6); PG8_BAR;
    } else {
        PG8_STAGE(PG8_SB(0, 0), cB, voffB); PG8_STAGE(PG8_SA(0, 0), cA, voffA); PG8_STAGE(PG8_SB(0, 1), cB + hstep, voffB); PG8_STAGE(PG8_SA(0, 1), cA + hstep, voffA);
        if (wr == 1) PG8_BAR;
        PG8_WAIT_V(4); PG8_BAR;
        PG8_STAGE(PG8_SB(1, 0), cB + kstep, voffB); PG8_STAGE(PG8_SA(1, 0), cA + kstep, voffA); PG8_STAGE(PG8_SB(1, 1), cB + hstep + kstep, voffB);
        PG8_WAIT_V(6); PG8_BAR;
    }
    for (;;) {
        const bool has_next = S.next(ui + 1, nxt);
        const char* nA = has_next ? (const char*)g.A + (size_t)nxt.pm * tstep : cA; const char* nB = has_next ? (const char*)g.Bt + (size_t)nxt.pn * tstep : cB;
        for (int t = 0; t < nt; t += 2) {
            const bool last = (t == nt - 2);
            const char* a1 = cA + (size_t)(t + 1) * kstep;
            const char* a2 = last ? nA : cA + (size_t)(t + 2) * kstep; const char* b2 = last ? nB : cB + (size_t)(t + 2) * kstep;
            const char* a3 = a2 + kstep; const char* b3 = b2 + kstep;
            if (last && has_next) S.a_ready(nxt);
            if constexpr (SP2) {
            PG8_LDB(B0, 0, 0); PG8_LDB(B1, 0, 1); PG8_SCHED; PG8_LDA(At, 0, 0); PG8_STAGE(PG8_SA(1, 1), a1 + hstep, voffA);
            PG8_WAIT_V(8); PG8_WAIT_L(0); PG8_BAR; PG8_MMA(0, 0, At, B0); PG8_MMA(0, 1, At, B1); PG8_BAR; PG8_SCHED;
            PG8_LDA(At, 0, 1); PG8_STAGE(PG8_SB(0, 0), b2, voffB); PG8_STAGE(PG8_SB(0, 1), b2 + hstep, voffB); PG8_STAGE(PG8_SA(0, 0), a2, voffA);
            PG8_WAIT_V(8); PG8_WAIT_L(0); PG8_BAR; PG8_MMA(1, 0, At, B0); PG8_MMA(1, 1, At, B1); PG8_BAR; PG8_SCHED;
            PG8_LDB(B0, 1, 0); PG8_LDB(B1, 1, 1); PG8_SCHED; PG8_LDA(At, 1, 0); PG8_STAGE(PG8_SA(0, 1), a2 + hstep, voffA);
            PG8_WAIT_V(8); PG8_WAIT_L(0); PG8_BAR; PG8_MMA(0, 0, At, B0); PG8_MMA(0, 1, At, B1); PG8_BAR; PG8_SCHED;
            PG8_LDA(At, 1, 1); PG8_STAGE(PG8_SB(1, 0), b3, voffB); PG8_STAGE(PG8_SB(1, 1), b3 + hstep, voffB); PG8_STAGE(PG8_SA(1, 0), a3, voffA);
            PG8_WAIT_V(8); PG8_WAIT_L(0); PG8_BAR; PG8_MMA(1, 0, At, B0); PG8_MMA(1, 1, At, B1); PG8_BAR; PG8_SCHED;
            } else {
            PG8_LDB(B0, 0, 0); PG8_SCHED; PG8_LDA(At, 0, 0); PG8_STAGE(PG8_SA(1, 1), a1 + hstep, voffA);
            PG8_WAIT_L(8); PG8_BAR; PG8_WAIT_L(0); PG8_MMA(0, 0, At, B0); PG8_BAR; PG8_SCHED;
            PG8_LDB(B1, 0, 1); PG8_STAGE(PG8_SB(0, 0), b2, voffB);
            PG8_BAR; PG8_WAIT_L(0); PG8_MMA(0, 1, At, B1); PG8_BAR;
            PG8_LDA(At, 0, 1); PG8_STAGE(PG8_SA(0, 0), a2, voffA);
            PG8_BAR; PG8_WAIT_L(0); PG8_MMA(1, 0, At, B0); PG8_BAR; PG8_SCHED;
            PG8_STAGE(PG8_SB(0, 1), b2 + hstep, voffB);
            PG8_WAIT_V(6); PG8_BAR; PG8_MMA(1, 1, At, B1); PG8_BAR;
            PG8_LDB(B0, 1, 0); PG8_SCHED; PG8_LDA(At, 1, 0); PG8_STAGE(PG8_SA(0, 1), a2 + hstep, voffA);
            PG8_WAIT_L(8); PG8_BAR; PG8_WAIT_L(0); PG8_MMA(0, 0, At, B0); PG8_BAR; PG8_SCHED;
            PG8_LDB(B1, 1, 1); PG8_STAGE(PG8_SB(1, 0), b3, voffB);
            PG8_BAR; PG8_WAIT_L(0); PG8_MMA(0, 1, At, B1); PG8_BAR;
            PG8_LDA(At, 1, 1); PG8_STAGE(PG8_SA(1, 0), a3, voffA);
            PG8_BAR; PG8_WAIT_L(0); PG8_MMA(1, 0, At, B0); PG8_BAR; PG8_SCHED;
            PG8_STAGE(PG8_SB(1, 1), b3 + hstep, voffB);
            PG8_WAIT_V(6); PG8_BAR; PG8_MMA(1, 1, At, B1); PG8_BAR;
            }
        }
        if constexpr (ALIGN_EPI) { if (wr == 0) PG8_BAR; }
        if constexpr (!Epi::AFTER_DRAIN) { E(acc, cur, wr, wc, fr, fq); S.done(cur); }
        if (!has_next) break;
#pragma unroll
        for (int a = 0; a < 2; ++a)
#pragma unroll
            for (int b = 0; b < 2; ++b)
#pragma unroll
                for (int m = 0; m < 4; ++m)
#pragma unroll
                    for (int n = 0; n < 2; ++n) acc[a][b][m][n] = (f32x4){0.f, 0.f, 0.f, 0.f};
        cur = nxt; cA = nA; cB = nB; ++ui;
        if constexpr (ALIGN_EPI) { if (wr == 1) PG8_BAR; }
    }
    PG8_WAIT_V(0);
    if constexpr (!ALIGN_EPI) { if (wr == 0) PG8_BAR; }
    PG8_BAR;
#undef PG8_SA
#undef PG8_SB
#undef PG8_STAGE
#undef PG8_LDA
#undef PG8_LDB
#undef PG8_MMA
#undef PG8_WAIT_V
#undef PG8_WAIT_L
#undef PG8_BAR
#undef PG8_SCHED
}
}
using pg8::cvtpk; using pg8::bflo; using pg8::bfhi;

#ifndef PG8_SP2
#define PG8_SP2 true
#endif
#ifndef PG8_ALIGN
#define PG8_ALIGN true
#endif

constexpr int RING_OFF = 0, RING_BYTES = 131072;
constexpr int LDSCTL_OFF = RING_BYTES, MISC_OFF = LDSCTL_OFF + 320;
constexpr int LDS_BYTES = 147456;
constexpr int NWAVES = 8;

typedef GAS unsigned gu32;
#define RLX_AGENT __ATOMIC_RELAXED, __HIP_MEMORY_SCOPE_AGENT
#define LDS_WAIT() asm volatile("s_waitcnt lgkmcnt(0)" ::: "memory")
#define VM_WAIT() asm volatile("s_waitcnt vmcnt(0)" ::: "memory")
DI unsigned f2bf(float f) { unsigned u = __builtin_bit_cast(unsigned, f); return (u + 0x7fffu + ((u >> 16) & 1u)) >> 16; }
DI unsigned pk2(float lo, float hi) { return f2bf(lo) | (f2bf(hi) << 16); }
DI float bf2f(bf16 v) { return __uint_as_float(((unsigned)v) << 16); }
DI float fexp(float x) { return __builtin_amdgcn_exp2f(x * LOG2E); }

#define XB_TMO      128
#define XB_XCNT(j)  (256  + 64 * (j))
#define XB_XSUB(j)  (1280 + 64 * (j))
#define XB_XGEN(j)  (2304 + 64 * (j))
#define XB_TOP      3328
#define XB_TOPGEN   3392
#define XCD_BAR_WORDS 3456
#define XB_SPIN_CAP (1u << 18)
constexpr int CW_BAR = 4096;
DI unsigned xb_ld(unsigned* p)              { return __hip_atomic_load(p, __ATOMIC_RELAXED, __HIP_MEMORY_SCOPE_AGENT); }
DI unsigned xb_add(unsigned* p, unsigned v) { return __hip_atomic_fetch_add(p, v, __ATOMIC_RELAXED, __HIP_MEMORY_SCOPE_AGENT); }
DI unsigned xb_xcc_id() { return (unsigned)__builtin_amdgcn_s_getreg((3 << 11) | 20) & 0xFu; }
#define XB_SPIN(cond, bar) do { unsigned _sp = 0; while (cond) { __builtin_amdgcn_s_sleep(1); \
    if ((++_sp & 255u) == 0u) { if (xb_ld(&(bar)[XB_TMO])) break; if (_sp > XB_SPIN_CAP) { atomicAdd(&(bar)[XB_TMO], 1u); break; } } } } while (0)
struct XcdBarrier { unsigned* bar; unsigned x; volatile LAS unsigned* st; };
DI XcdBarrier xcd_barrier_post(unsigned* bar, volatile LAS unsigned* st) {
    XcdBarrier b; b.bar = bar; b.x = xb_xcc_id(); b.st = st;
    if (threadIdx.x == 0) (void)xb_add(&bar[XB_XCNT(b.x)], 1u);
    return b;
}
DI void xcd_barrier_complete(unsigned* bar, unsigned x, unsigned& nloc, unsigned& nx) {
    const unsigned G = gridDim.x * gridDim.y * gridDim.z;
    unsigned sum, cnt, mine, sp = 0u;
    for (;;) {
        sum = 0u; cnt = 0u; mine = 0u;
#pragma unroll
        for (unsigned j = 0; j < 16; ++j) { const unsigned c = xb_ld(&bar[XB_XCNT(j)]); sum += c; cnt += (c > 0u) ? 1u : 0u; mine = (j == x) ? c : mine; }
        if (sum == G) break;
        __builtin_amdgcn_s_sleep(1);
        if ((++sp & 255u) == 0u) { if (xb_ld(&bar[XB_TMO])) break; if (sp > XB_SPIN_CAP) { atomicAdd(&bar[XB_TMO], 1u); break; } }
    }
    nloc = mine > 0u ? mine : 1u; nx = cnt > 0u ? cnt : 1u;
}
DI void xcd_barrier(const XcdBarrier& b) {
    asm volatile("s_waitcnt vmcnt(0)" ::: "memory");
    __syncthreads();
    if (threadIdx.x == 0) {
        unsigned* bar = b.bar;
        __builtin_amdgcn_s_waitcnt(0);
        unsigned nloc = b.st[0], nx = b.st[1];
        if (nloc == 0u) { xcd_barrier_complete(bar, b.x, nloc, nx); b.st[0] = nloc; b.st[1] = nx; }
        const unsigned old = xb_add(&bar[XB_XSUB(b.x)], 1u);
        const unsigned gen = old / nloc;
        if (old + 1u == (gen + 1u) * nloc) {
            __builtin_amdgcn_fence(__ATOMIC_RELEASE, "agent");
            asm volatile("s_waitcnt vmcnt(0)" ::: "memory");
            const unsigned og = xb_add(&bar[XB_TOP], 1u);
            const unsigned tg = og / nx;
            if (og + 1u == (tg + 1u) * nx) xb_add(&bar[XB_TOPGEN], 1u);
            else XB_SPIN(xb_ld(&bar[XB_TOPGEN]) == tg, bar);
            __builtin_amdgcn_fence(__ATOMIC_ACQUIRE, "agent");
            xb_add(&bar[XB_XGEN(b.x)], 1u);
            asm volatile("s_waitcnt vmcnt(0)" ::: "memory");
        } else {
            XB_SPIN(xb_ld(&bar[XB_XGEN(b.x)]) == gen, bar);
            __builtin_amdgcn_fence(__ATOMIC_ACQUIRE, "agent");
            asm volatile("s_waitcnt vmcnt(0)" ::: "memory");
        }
    }
    __syncthreads();
}

struct Args { const float* in[21]; float* out; unsigned char* ws; int ph_lo, ph_hi; };
struct Frame {
    LAS unsigned char* lds;
    int tid, lane, wave, vcu, G;
    const float* in[21]; float* out; unsigned char* ws;
};
DI float wave_sum(float v) {
#pragma unroll
    for (int o = 1; o < 64; o <<= 1) v += __shfl_xor(v, o);
    return v;
}

template <class F> DI void wt_item(F val, int K, bf16* WT, int nblk, LAS float* scr, int item, int lane) {
    const int kb = item / nblk, nb = item % nblk, k0 = 64 * kb, n0 = 32 * nb;
#pragma unroll 4
    for (int i = 0; i < 32; ++i) { const int kk = 2 * i + (lane >> 5); scr[kk * 33 + (lane & 31)] = val(k0 + kk, n0 + (lane & 31)); }
    LDS_WAIT(); asm volatile("" ::: "memory");
    const int c = lane & 7;
#pragma unroll
    for (int j = 0; j < 4; ++j) { const int n = (lane >> 3) + 8 * j; const LAS float* s = scr + (8 * c) * 33 + n;
        u32x4 o; o.x = pk2(s[0 * 33], s[1 * 33]); o.y = pk2(s[2 * 33], s[3 * 33]); o.z = pk2(s[4 * 33], s[5 * 33]); o.w = pk2(s[6 * 33], s[7 * 33]);
        *(u32x4*)(WT + (size_t)(n0 + n) * K + k0 + 8 * c) = o; }
    LDS_WAIT(); asm volatile("" ::: "memory");
}
DI void norm_row_to_bf16(int lane, const float* xrow, const f32x4 (&w)[4], bf16* orow) {
    const f32x4* xr = (const f32x4*)xrow + lane;
    f32x4 v[4]; float s = 0.f;
#pragma unroll
    for (int j = 0; j < 4; ++j) { v[j] = xr[64 * j]; s += (v[j].x * v[j].x + v[j].y * v[j].y) + (v[j].z * v[j].z + v[j].w * v[j].w); }
    const float rstd = rsqrtf(wave_sum(s) * (1.f / DM) + EPS);
    u32x2* o8 = (u32x2*)orow + lane;
#pragma unroll
    for (int j = 0; j < 4; ++j) { u32x2 o; o.x = cvtpk(v[j].x * rstd * w[j].x, v[j].y * rstd * w[j].y); o.y = cvtpk(v[j].z * rstd * w[j].z, v[j].w * rstd * w[j].w); o8[64 * j] = o; }
}
DI void p0_prologue(Frame& F) {
    LAS float* scr = (LAS float*)(F.lds + RING_OFF + F.wave * 16384);
    const int gw = F.vcu * NWAVES + F.wave, NGW = F.G * NWAVES, lane = F.lane;
    const float* win = F.in[3]; const float* pw = F.in[4]; const float* ps = F.in[5]; const float* gw2 = F.in[6];
    const float* wout = F.in[9]; const float* nxw = F.in[10]; const float* wq = F.in[12]; const float* wkv = F.in[13]; const float* wxo = F.in[14];
    const float* nfw = F.in[15]; const float* wup = F.in[16]; const float* wdn = F.in[19];
    bf16* W1T = (bf16*)(F.ws + WS_W1T); bf16* WOT = (bf16*)(F.ws + WS_WOT); bf16* WQT = (bf16*)(F.ws + WS_WQT); bf16* WKT = (bf16*)(F.ws + WS_WKT);
    bf16* WVT = (bf16*)(F.ws + WS_WVT); bf16* WXOT = (bf16*)(F.ws + WS_WXOT); bf16* WUT = (bf16*)(F.ws + WS_WUT); bf16* WDT = (bf16*)(F.ws + WS_WDT);
    constexpr int I_Y = 16 * 16, I_QKV = 16 * 32, I_G = 16 * 8, I_R = 16 * 16, I_SQ = 16 * 32, I_UP = 16 * 176, I_DN = 44 * 32;
    constexpr int NITEMS = I_Y + I_QKV + I_G + I_R + 5 * I_SQ + I_UP + I_DN;
    for (int it = gw; it < NITEMS; it += NGW) {
        int r = it;
        if (r < I_Y) {
            wt_item([&](int k, int n) { const int g = n >> 7, d = n & 127; const float* a = win + (size_t)k * WIN_LD + g * 128; const float* b = pw + (size_t)g * 16384 + d; float s = 0.f;
#pragma unroll 8
                for (int c = 0; c < 128; ++c) s += a[c] * b[c * 128];
                return s * ps[n]; }, DM, W1T, 16, scr, r, lane); continue; } r -= I_Y;
        if (r < I_QKV) {
            wt_item([&](int k, int n) { const float v = win[(size_t)k * WIN_LD + 512 + n]; return n < 256 ? v * 0.125f : v; }, DM, W1T + (size_t)C_Q * DM, 32, scr, r, lane); continue; } r -= I_QKV;
        if (r < I_G) {
            wt_item([&](int k, int n) { const float* a = win + (size_t)k * WIN_LD + 1536; float s = 0.f;
#pragma unroll
                for (int c = 0; c < 16; ++c) s += a[c] * gw2[c * 256 + n];
                return s; }, DM, W1T + (size_t)C_LG * DM, 8, scr, r, lane); continue; } r -= I_G;
        if (r < I_R) { wt_item([&](int k, int n) { return win[(size_t)k * WIN_LD + 1552 + n]; }, DM, W1T + (size_t)C_SR * DM, 16, scr, r, lane); continue; } r -= I_R;
        if (r < I_SQ) { wt_item([&](int k, int n) { return wout[(size_t)k * DM + n]; }, DM, WOT, 32, scr, r, lane); continue; } r -= I_SQ;
        if (r < I_SQ) { wt_item([&](int k, int n) { return wq[(size_t)k * DM + n] * nxw[k]; }, DM, WQT, 32, scr, r, lane); continue; } r -= I_SQ;
        if (r < I_SQ) { wt_item([&](int k, int n) { return wkv[(size_t)k * 2048 + n]; }, DM, WKT, 32, scr, r, lane); continue; } r -= I_SQ;
        if (r < I_SQ) { wt_item([&](int k, int n) { return wkv[(size_t)k * 2048 + 1024 + n]; }, DM, WVT, 32, scr, r, lane); continue; } r -= I_SQ;
        if (r < I_SQ) { wt_item([&](int k, int n) { return wxo[(size_t)k * DM + n]; }, DM, WXOT, 32, scr, r, lane); continue; } r -= I_SQ;
        if (r < I_UP) {
            wt_item([&](int k, int n) { const int pn = n >> 8, bj = (n >> 7) & 1, j = n & 127; return wup[(size_t)k * NUP + bj * FF + pn * 128 + j] * nfw[k]; }, DM, WUT, 176, scr, r, lane); continue; } r -= I_UP;
        wt_item([&](int k, int n) { return wdn[(size_t)k * DM + n]; }, FF, WDT, 32, scr, r, lane);
    }
    { float* ss = (float*)(F.ws + WS_SS); for (int i = (F.vcu * 512 + F.tid); i < 3 * T; i += F.G * 512) ss[i] = 0.f; }
    { const float* w = F.in[2]; f32x4 wv[4];
#pragma unroll
      for (int j = 0; j < 4; ++j) wv[j] = ((const f32x4*)w)[lane + 64 * j];
      bf16* H1 = (bf16*)(F.ws + WS_H1);
      for (int m = gw; m < T; m += NGW) norm_row_to_bf16(lane, F.in[0] + (size_t)m * DM, wv, H1 + (size_t)m * DM); }
    { const float* w = F.in[11]; f32x4 wv[4];
#pragma unroll
      for (int j = 0; j < 4; ++j) wv[j] = ((const f32x4*)w)[lane + 64 * j];
      bf16* MN = (bf16*)(F.ws + WS_MN);
      for (int m = gw; m < TM; m += NGW) norm_row_to_bf16(lane, F.in[1] + (size_t)m * DM, wv, MN + (size_t)m * DM); }
}

DI int crow(int reg, int h) { return (reg & 3) + 8 * (reg >> 2) + 4 * h; }
#define MFMA32(a, b, c) __builtin_amdgcn_mfma_f32_32x32x16_bf16((a), (b), (c), 0, 0, 0)
constexpr int GP = 144;
DI void mma_tile(f32x16& acc, LAS const unsigned char* A, LAS const unsigned char* B, int ksteps, int lane) {
    const int r = lane & 31, h = lane >> 5;
    LAS const unsigned char* ap = A + r * GP + 16 * h; LAS const unsigned char* bp = B + r * GP + 16 * h;
    for (int ks = 0; ks < ksteps; ++ks) { const bf16x8 a = *(const LAS bf16x8*)(ap + 32 * ks), b = *(const LAS bf16x8*)(bp + 32 * ks); acc = MFMA32(a, b, acc); }
}
DI void gla_item(Frame& F, int b, int h) {
    LAS unsigned char* L = F.lds;
    constexpr int QD = 0, KD = QD + 64 * GP, KET = KD + 64 * GP, VTL = KET + 64 * GP, SC = VTL + 128 * GP, STL = SC + 64 * GP, OL = STL + 128 * GP, OLP = 528,
                  DEC = OL + 64 * OLP, TOT = DEC + 256, GEND = TOT + 2048;
    static_assert(GEND <= RING_BYTES, "GLA LDS");
    const int tid = F.tid, lane = F.lane, wave = F.wave, r = lane & 31, hh = lane >> 5;
    const bf16* proj = (const bf16*)(F.ws + WS_PROJ); bf16* mix = (bf16*)(F.ws + WS_MIX); const float* gnw = F.in[8];
    for (int i = tid; i < 128 * GP / 4; i += 512) ((LAS unsigned*)(L + STL))[i] = 0u;
    f32x16 accS;
#pragma unroll
    for (int i = 0; i < 16; ++i) accS[i] = 0.f;
    const int it_o = wave >> 2, et_o = wave & 3, et_s = wave >> 1, dt_s = wave & 1;
    __syncthreads();
    for (int n = 0; n < SEQ / 64; ++n) {
        const size_t tok0 = (size_t)b * SEQ + 64 * n;
        const bf16* base = proj + tok0 * N1;
        {
            const int d = tid & 63, tg = tid >> 6;
            float lgv[8], qv[8], kv[8];
#pragma unroll
            for (int ii = 0; ii < 8; ++ii) { const bf16* rp = base + (size_t)(8 * tg + ii) * N1 + 64 * h + d; lgv[ii] = bf2f(rp[C_LG]); qv[ii] = bf2f(rp[C_Q]); kv[ii] = bf2f(rp[C_K]); }
            {
                const int e = tid & 127, tq = tid >> 7; unsigned pkv[8];
#pragma unroll
                for (int jj = 0; jj < 8; ++jj) { const bf16* rp = base + (size_t)(16 * tq + 2 * jj) * N1 + C_V + 128 * h + e; pkv[jj] = (unsigned)rp[0] | ((unsigned)rp[N1] << 16); }
                LAS u32x4* dst = (LAS u32x4*)(L + VTL + e * GP + tq * 32);
                dst[0] = (u32x4){pkv[0], pkv[1], pkv[2], pkv[3]}; dst[1] = (u32x4){pkv[4], pkv[5], pkv[6], pkv[7]};
            }
#pragma unroll
            for (int ii = 1; ii < 8; ++ii) lgv[ii] += lgv[ii - 1];
            ((LAS float*)(L + TOT))[tg * 64 + d] = lgv[7];
            __syncthreads();
            float pre = 0.f, tot = 0.f;
#pragma unroll
            for (int g = 0; g < 8; ++g) { const float t = ((LAS float*)(L + TOT))[g * 64 + d]; tot += t; pre += (g < tg) ? t : 0.f; }
            unsigned kep[4];
#pragma unroll
            for (int ii = 0; ii < 8; ii += 2) {
                const float G0 = pre + lgv[ii], G1 = pre + lgv[ii + 1];
                const float q0 = qv[ii] * fexp(G0), q1 = qv[ii + 1] * fexp(G1);
                const float k0 = kv[ii] * fexp(-G0), k1 = kv[ii + 1] * fexp(-G1);
                const float e0 = kv[ii] * fexp(tot - G0), e1 = kv[ii + 1] * fexp(tot - G1);
                *(LAS bf16*)(L + QD + (8 * tg + ii) * GP + 2 * d) = (bf16)f2bf(q0); *(LAS bf16*)(L + QD + (8 * tg + ii + 1) * GP + 2 * d) = (bf16)f2bf(q1);
                *(LAS bf16*)(L + KD + (8 * tg + ii) * GP + 2 * d) = (bf16)f2bf(k0); *(LAS bf16*)(L + KD + (8 * tg + ii + 1) * GP + 2 * d) = (bf16)f2bf(k1);
                kep[ii >> 1] = cvtpk(e0, e1);
            }
            *(LAS u32x4*)(L + KET + d * GP + tg * 16) = (u32x4){kep[0], kep[1], kep[2], kep[3]};
            if (tg == 0) ((LAS float*)(L + DEC))[d] = fexp(tot);
        }
        __syncthreads();
        f32x16 acc_o;
#pragma unroll
        for (int i = 0; i < 16; ++i) acc_o[i] = 0.f;
        if (wave < 3) {
            const int it = (wave >= 1) ? 1 : 0, jt = (wave == 2) ? 1 : 0;
            f32x16 sc;
#pragma unroll
            for (int i = 0; i < 16; ++i) sc[i] = 0.f;
            mma_tile(sc, L + QD + it * 32 * GP, L + KD + jt * 32 * GP, 4, lane);
#pragma unroll
            for (int reg = 0; reg < 16; ++reg) { const int i = 32 * it + crow(reg, hh), j = 32 * jt + r; const float v = (j <= i) ? sc[reg] : 0.f; *(LAS bf16*)(L + SC + i * GP + 2 * j) = (bf16)f2bf(v); }
        }
        mma_tile(acc_o, L + QD + it_o * 32 * GP, L + STL + et_o * 32 * GP, 4, lane);
        { const float dec = ((LAS float*)(L + DEC))[32 * dt_s + r];
#pragma unroll
          for (int i = 0; i < 16; ++i) accS[i] *= dec;
          mma_tile(accS, L + VTL + et_s * 32 * GP, L + KET + dt_s * 32 * GP, 4, lane); }
        __syncthreads();
        mma_tile(acc_o, L + SC + it_o * 32 * GP, L + VTL + et_o * 32 * GP, 2 * (it_o + 1), lane);
#pragma unroll
        for (int reg = 0; reg < 16; ++reg) {
            *(LAS bf16*)(L + STL + (32 * et_s + crow(reg, hh)) * GP + 2 * (32 * dt_s + r)) = (bf16)f2bf(accS[reg]);
            *(LAS float*)(L + OL + (32 * it_o + crow(reg, hh)) * OLP + 4 * (32 * et_o + r)) = acc_o[reg];
        }
        __syncthreads();
        {
            const int i = tid >> 3, eg = tid & 7; float o[16]; float s = 0.f;
#pragma unroll
            for (int q = 0; q < 4; ++q) { const f32x4 v = *(LAS const f32x4*)(L + OL + i * OLP + 64 * eg + 16 * q); o[4 * q] = v[0]; o[4 * q + 1] = v[1]; o[4 * q + 2] = v[2]; o[4 * q + 3] = v[3]; s += (v[0] * v[0] + v[1] * v[1]) + (v[2] * v[2] + v[3] * v[3]); }
            s += __shfl_xor(s, 1); s += __shfl_xor(s, 2); s += __shfl_xor(s, 4);
            const float rstd = rsqrtf(s * (1.f / 128.f) + EPS);
            const bf16* srp = base + (size_t)i * N1 + C_SR + 128 * h + 16 * eg;
            const u32x4 s0 = *(const u32x4*)srp, s1 = *(const u32x4*)(srp + 8);
            const unsigned sw[8] = {s0.x, s0.y, s0.z, s0.w, s1.x, s1.y, s1.z, s1.w};
            unsigned ow[8];
#pragma unroll
            for (int q = 0; q < 8; ++q) { const float g0 = gnw[16 * eg + 2 * q], g1 = gnw[16 * eg + 2 * q + 1]; ow[q] = cvtpk(o[2 * q] * rstd * g0 * bflo(sw[q]), o[2 * q + 1] * rstd * g1 * bfhi(sw[q])); }
            bf16* op = mix + (tok0 + i) * DM + 512 + 128 * h + 16 * eg;
            *(u32x4*)op = (u32x4){ow[0], ow[1], ow[2], ow[3]}; *(u32x4*)(op + 8) = (u32x4){ow[4], ow[5], ow[6], ow[7]};
        }
    }
}
DI void pool_item(Frame& F, int item) {
    const int lane = F.lane, b = item >> 5, blk = item & 31, c0 = 8 * lane, w = 2 << (lane >> 4);
    const bf16* proj = (const bf16*)(F.ws + WS_PROJ); bf16* mix = (bf16*)(F.ws + WS_MIX);
    const size_t seq0 = (size_t)b * SEQ; const int p0 = 64 * blk;
    float s[8];
#pragma unroll
    for (int j = 0; j < 8; ++j) s[j] = 0.f;
    for (int k = 15; k >= 1; --k) { const int p = p0 - k; if (k <= w - 1 && p >= 0) { const u32x4 v = *(const u32x4*)(proj + (seq0 + p) * N1 + c0);
        s[0] += bflo(v.x); s[1] += bfhi(v.x); s[2] += bflo(v.y); s[3] += bfhi(v.y); s[4] += bflo(v.z); s[5] += bfhi(v.z); s[6] += bflo(v.w); s[7] += bfhi(v.w); } }
    for (int t = 0; t < 64; ++t) {
        const int p = p0 + t; const u32x4 v = *(const u32x4*)(proj + (seq0 + p) * N1 + c0);
        const float y[8] = {bflo(v.x), bfhi(v.x), bflo(v.y), bfhi(v.y), bflo(v.z), bfhi(v.z), bflo(v.w), bfhi(v.w)};
        const float inv = 1.f / (float)((p + 1) < w ? (p + 1) : w);
        float o[8];
#pragma unroll
        for (int j = 0; j < 8; ++j) { s[j] += y[j]; o[j] = s[j] * inv - y[j]; }
        *(u32x4*)(mix + (seq0 + p) * DM + c0) = (u32x4){cvtpk(o[0], o[1]), cvtpk(o[2], o[3]), cvtpk(o[4], o[5]), cvtpk(o[6], o[7])};
        const int pd = p - w + 1;
        if (pd >= 0) { const u32x4 u = *(const u32x4*)(proj + (seq0 + pd) * N1 + c0);
            s[0] -= bflo(u.x); s[1] -= bfhi(u.x); s[2] -= bflo(u.y); s[3] -= bfhi(u.y); s[4] -= bflo(u.z); s[5] -= bfhi(u.z); s[6] -= bflo(u.w); s[7] -= bfhi(u.w); }
    }
}

DI void attn_wave_unit(Frame& F, int unit) {
    const int lane = F.lane, r = lane & 31, hh = lane >> 5;
    const int qb = unit & 63, bh = unit >> 6, b = bh >> 2, h = bh & 3;
    const bf16* Q = (const bf16*)(F.ws + WS_H1); const bf16* KB = (const bf16*)(F.ws + WS_KB); const bf16* VT = (const bf16*)(F.ws + WS_VT); bf16* O = (bf16*)(F.ws + WS_MIX);
    const size_t t0 = (size_t)b * SEQ + 32 * qb;
    bf16x8 qf[16];
    { const bf16* qp = Q + (t0 + r) * DM + 256 * h + 8 * hh;
#pragma unroll
      for (int ks = 0; ks < 16; ++ks) qf[ks] = *(const bf16x8*)(qp + 16 * ks); }
    f32x16 sacc[8];
    const bf16* kp = KB + ((size_t)b * NMEM + r) * DM + 256 * h + 8 * hh;
#pragma unroll
    for (int kt = 0; kt < 8; ++kt) {
#pragma unroll
        for (int i = 0; i < 16; ++i) sacc[kt][i] = 0.f;
#pragma unroll
        for (int ks = 0; ks < 16; ++ks) { const bf16x8 kf = *(const bf16x8*)(kp + (size_t)(32 * kt) * DM + 16 * ks); sacc[kt] = MFMA32(kf, qf[ks], sacc[kt]); }
    }
    float mx = sacc[0][0];
#pragma unroll
    for (int kt = 0; kt < 8; ++kt)
#pragma unroll
        for (int i = 0; i < 16; ++i) mx = fmaxf(mx, sacc[kt][i]);
    mx = fmaxf(mx, __shfl_xor(mx, 32));
    float sum = 0.f;
#pragma unroll
    for (int kt = 0; kt < 8; ++kt)
#pragma unroll
        for (int i = 0; i < 16; ++i) { const float p = __builtin_amdgcn_exp2f(sacc[kt][i] - mx); sacc[kt][i] = p; sum += p; }
    sum += __shfl_xor(sum, 32);
    const float inv = 1.f / sum;
    bf16x8 pf[8][2];
#pragma unroll
    for (int kt = 0; kt < 8; ++kt)
#pragma unroll
        for (int s = 0; s < 2; ++s) { u32x4 p; p.x = cvtpk(sacc[kt][8 * s], sacc[kt][8 * s + 1]); p.y = cvtpk(sacc[kt][8 * s + 2], sacc[kt][8 * s + 3]); p.z = cvtpk(sacc[kt][8 * s + 4], sacc[kt][8 * s + 5]); p.w = cvtpk(sacc[kt][8 * s + 6], sacc[kt][8 * s + 7]);
            pf[kt][s] = __builtin_bit_cast(bf16x8, p); }
    const bf16* vp = VT + ((size_t)(256 * h) + r) * TM + (size_t)b * NMEM + 4 * hh;
    bf16* op = O + (t0 + r) * DM + 256 * h + 4 * hh;
#pragma unroll 1
    for (int dt = 0; dt < 8; ++dt) {
        f32x16 oacc;
#pragma unroll
        for (int i = 0; i < 16; ++i) oacc[i] = 0.f;
        const bf16* vrow = vp + (size_t)(32 * dt) * TM;
#pragma unroll
        for (int kt = 0; kt < 8; ++kt)
#pragma unroll
            for (int s = 0; s < 2; ++s) { const u32x2 lo = *(const u32x2*)(vrow + 32 * kt + 16 * s), hi = *(const u32x2*)(vrow + 32 * kt + 16 * s + 8);
                const bf16x8 vf = __builtin_bit_cast(bf16x8, (u32x4){lo.x, lo.y, hi.x, hi.y}); oacc = MFMA32(vf, pf[kt][s], oacc); }
#pragma unroll
        for (int g = 0; g < 4; ++g) { u32x2 w; w.x = cvtpk(oacc[4 * g] * inv, oacc[4 * g + 1] * inv); w.y = cvtpk(oacc[4 * g + 2] * inv, oacc[4 * g + 3] * inv); *(u32x2*)(op + 32 * dt + 8 * g) = w; }
    }
}

DI void conv_half(Frame& F, int half) {
    const bf16* U = (const bf16*)(F.ws + WS_UH); bf16* ACT = (bf16*)(F.ws + WS_ACT);
    const float* cw = F.in[17]; const float* cb = F.in[18];
    constexpr int RUN = 32, NCG = FF / 8, NITEM = (T / 2 / RUN) * NCG;
    for (int item = F.vcu * 512 + F.tid; item < NITEM; item += F.G * 512) {
        const int rr = item / NCG, cg = item - rr * NCG, ca = 8 * cg, pn = ca >> 7, j = ca & 127;
        const int ucol = 256 * pn + j;
        float wg[3][8], wv[3][8], bg[8], bv[8];
#pragma unroll
        for (int t = 0; t < 3; ++t)
#pragma unroll
            for (int q = 0; q < 8; ++q) { wg[t][q] = cw[t * NUP + ca + q]; wv[t][q] = cw[t * NUP + FF + ca + q]; }
#pragma unroll
        for (int q = 0; q < 8; ++q) { bg[q] = cb[ca + q]; bv[q] = cb[FF + ca + q]; }
        const int lr0 = rr * RUN;
        const int pos0 = (lr0 & (SEQ - 1));
        float g1[8], g2[8], v1[8], v2[8];
#pragma unroll
        for (int q = 0; q < 8; ++q) { g1[q] = g2[q] = v1[q] = v2[q] = 0.f; }
        if (pos0 >= 2) {
            const u32x4 a = *(const u32x4*)(U + (size_t)(lr0 - 2) * NUP + ucol), b = *(const u32x4*)(U + (size_t)(lr0 - 2) * NUP + ucol + 128);
            const u32x4 c = *(const u32x4*)(U + (size_t)(lr0 - 1) * NUP + ucol), d = *(const u32x4*)(U + (size_t)(lr0 - 1) * NUP + ucol + 128);
            const unsigned aw[4] = {a.x, a.y, a.z, a.w}, bw[4] = {b.x, b.y, b.z, b.w}, cw4[4] = {c.x, c.y, c.z, c.w}, dw[4] = {d.x, d.y, d.z, d.w};
#pragma unroll
            for (int q = 0; q < 4; ++q) { g2[2 * q] = bflo(aw[q]); g2[2 * q + 1] = bfhi(aw[q]); v2[2 * q] = bflo(bw[q]); v2[2 * q + 1] = bfhi(bw[q]);
                g1[2 * q] = bflo(cw4[q]); g1[2 * q + 1] = bfhi(cw4[q]); v1[2 * q] = bflo(dw[q]); v1[2 * q + 1] = bfhi(dw[q]); }
        }
        for (int t = 0; t < RUN; ++t) {
            const size_t lr = (size_t)(lr0 + t);
            const u32x4 a = *(const u32x4*)(U + lr * NUP + ucol), b = *(const u32x4*)(U + lr * NUP + ucol + 128);
            const unsigned aw[4] = {a.x, a.y, a.z, a.w}, bw[4] = {b.x, b.y, b.z, b.w};
            float g0[8], v0[8]; unsigned ow[4];
#pragma unroll
            for (int q = 0; q < 4; ++q) { g0[2 * q] = bflo(aw[q]); g0[2 * q + 1] = bfhi(aw[q]); v0[2 * q] = bflo(bw[q]); v0[2 * q + 1] = bfhi(bw[q]); }
            float o[8];
#pragma unroll
            for (int q = 0; q < 8; ++q) {
                const float gg = bg[q] + wg[0][q] * g2[q] + wg[1][q] * g1[q] + wg[2][q] * g0[q];
                const float vv = bv[q] + wv[0][q] * v2[q] + wv[1][q] * v1[q] + wv[2][q] * v0[q];
                o[q] = gg * __builtin_amdgcn_rcpf(1.f + __expf(-gg)) * vv;
                g2[q] = g1[q]; g1[q] = g0[q]; v2[q] = v1[q]; v1[q] = v0[q];
            }
#pragma unroll
            for (int q = 0; q < 4; ++q) ow[q] = cvtpk(o[2 * q], o[2 * q + 1]);
            *(u32x4*)(ACT + ((size_t)half * (T / 2) + lr) * FF + ca) = (u32x4){ow[0], ow[1], ow[2], ow[3]};
        }
    }
}

DI void final_norm(Frame& F) {
    const int gw = F.vcu * NWAVES + F.wave, NGW = F.G * NWAVES, lane = F.lane;
    const float* ss = (const float*)(F.ws + WS_SS) + 2 * T; const float* w = F.in[20];
    f32x4 wv[4];
#pragma unroll
    for (int j = 0; j < 4; ++j) wv[j] = ((const f32x4*)w)[lane + 64 * j];
    for (int m = gw; m < T; m += NGW) {
        const float rstd = rsqrtf(ss[m] * (1.f / DM) + EPS);
        f32x4* p = (f32x4*)(F.out + (size_t)m * DM) + lane;
#pragma unroll
        for (int j = 0; j < 4; ++j) { f32x4 v = p[64 * j]; v = v * rstd * wv[j]; p[64 * j] = v; }
    }
}

__global__ void __launch_bounds__(NWAVES * 64, 2) hymba_fwd(Args args) {
    extern __shared__ __attribute__((aligned(16))) unsigned char lds[];
    Frame F;
    F.lds = (LAS unsigned char*)lds;
    F.tid = threadIdx.x; F.lane = F.tid & 63; F.wave = __builtin_amdgcn_readfirstlane(F.tid >> 6);
    F.G = gridDim.x; { const int bx = blockIdx.x; F.vcu = (F.G % 8 == 0) ? (bx % 8) * (F.G / 8) + bx / 8 : bx; }
#pragma unroll
    for (int i = 0; i < 21; ++i) F.in[i] = args.in[i];
    F.out = args.out; F.ws = args.ws;
    volatile LAS unsigned* MISC = (volatile LAS unsigned*)(F.lds + MISC_OFF);
    for (int u = F.tid; u < (LDS_BYTES - LDSCTL_OFF) / 4; u += NWAVES * 64) ((LAS unsigned*)(F.lds + LDSCTL_OFF))[u] = 0u;
    __syncthreads();
    const int lo = args.ph_lo, hi = args.ph_hi;
    XcdBarrier bar; bar.bar = (unsigned*)(F.ws + WS_CTL) + CW_BAR; bar.x = 0; bar.st = nullptr;
    if (hi - lo > 1) bar = xcd_barrier_post((unsigned*)(F.ws + WS_CTL) + CW_BAR, MISC + 8);
#define IN(k) (lo <= (k) && (k) < hi)
#define SEAM(k) do { if (IN(k) && IN((k) + 1)) xcd_barrier(bar); } while (0)
    const int cid = (int)blockIdx.x;
    bf16* W1T = (bf16*)(F.ws + WS_W1T); bf16* WOT = (bf16*)(F.ws + WS_WOT); bf16* WQT = (bf16*)(F.ws + WS_WQT); bf16* WKT = (bf16*)(F.ws + WS_WKT);
    bf16* WVT = (bf16*)(F.ws + WS_WVT); bf16* WXOT = (bf16*)(F.ws + WS_WXOT); bf16* WUT = (bf16*)(F.ws + WS_WUT); bf16* WDT = (bf16*)(F.ws + WS_WDT);
    bf16* H1 = (bf16*)(F.ws + WS_H1); bf16* PROJ = (bf16*)(F.ws + WS_PROJ); bf16* MIX = (bf16*)(F.ws + WS_MIX); bf16* X1B = (bf16*)(F.ws + WS_X1B);
    bf16* MN = (bf16*)(F.ws + WS_MN); bf16* KB = (bf16*)(F.ws + WS_KB); bf16* VT = (bf16*)(F.ws + WS_VT); bf16* ACT = (bf16*)(F.ws + WS_ACT); bf16* UH = (bf16*)(F.ws + WS_UH);
    float* SS1 = (float*)(F.ws + WS_SS); float* SS2 = SS1 + T; float* SS3 = SS2 + T;

    if (IN(0)) { p0_prologue(F); } SEAM(0);
    if (IN(1)) {
        { pg8::Gemm g{H1, W1T, T, N1, DM}; pg8::StaticOrder S; S.init(T, N1, F.G, cid); pg8::EpiG1 E{PROJ, F.in[7]};
          pg8::gemm_phase<pg8::EpiG1, pg8::StaticOrder, PG8_ALIGN, PG8_SP2>(F.lds + RING_OFF, g, S, E); }
        { pg8::Gemm g{MN, WKT, TM, DM, DM}; pg8::StaticOrder S; S.init(TM, DM, F.G, cid); pg8::EpiBf16<false> E{KB, DM, nullptr, 1.f};
          pg8::gemm_phase<pg8::EpiBf16<false>, pg8::StaticOrder, PG8_ALIGN, PG8_SP2>(F.lds + RING_OFF, g, S, E); }
        { pg8::Gemm g{WVT, MN, DM, TM, DM}; pg8::StaticOrder S; S.init(DM, TM, F.G, (cid + F.G / 2) % F.G); pg8::EpiBf16<false> E{VT, TM, nullptr, 1.f};
          pg8::gemm_phase<pg8::EpiBf16<false>, pg8::StaticOrder, PG8_ALIGN, PG8_SP2>(F.lds + RING_OFF, g, S, E); }
    } SEAM(1);
    if (IN(2)) {
        if (cid < 128) gla_item(F, cid >> 2, cid & 3);
        else { for (int item = (cid - 128) * NWAVES + F.wave; item < NB * (SEQ / 64); item += (F.G - 128) * NWAVES) pool_item(F, item); }
    } SEAM(2);
    if (IN(3)) { pg8::Gemm g{MIX, WOT, T, DM, DM}; pg8::StaticOrder S; S.init(T, DM, F.G, cid); pg8::EpiRes<true> E{F.in[0], X1B, SS1};
        pg8::gemm_phase<pg8::EpiRes<true>, pg8::StaticOrder, PG8_ALIGN, PG8_SP2>(F.lds + RING_OFF, g, S, E); } SEAM(3);
    if (IN(4)) { pg8::Gemm g{X1B, WQT, T, DM, DM}; pg8::StaticOrder S; S.init(T, DM, F.G, cid); pg8::EpiBf16<true> E{H1, DM, SS1, 0.0625f * LOG2E};
        pg8::gemm_phase<pg8::EpiBf16<true>, pg8::StaticOrder, PG8_ALIGN, PG8_SP2>(F.lds + RING_OFF, g, S, E); } SEAM(4);
    if (IN(5)) { for (int unit = cid * NWAVES + F.wave; unit < NB * 4 * (SEQ / 32); unit += F.G * NWAVES) attn_wave_unit(F, unit); } SEAM(5);
    if (IN(6)) { pg8::Gemm g{MIX, WXOT, T, DM, DM}; pg8::StaticOrder S; S.init(T, DM, F.G, cid); pg8::EpiRes<false> E{X1B, X1B, SS2};
        pg8::gemm_phase<pg8::EpiRes<false>, pg8::StaticOrder, PG8_ALIGN, PG8_SP2>(F.lds + RING_OFF, g, S, E); } SEAM(6);
#pragma unroll 1
    for (int half = 0; half < 2; ++half) {
        if (IN(7 + 2 * half)) { pg8::Gemm g{X1B + (size_t)half * (T / 2) * DM, WUT, T / 2, NUP, DM}; pg8::StaticOrder S; S.init(T / 2, NUP, F.G, cid);
            pg8::EpiBf16<true> E{UH, NUP, SS2 + half * (T / 2), 1.f};
            pg8::gemm_phase<pg8::EpiBf16<true>, pg8::StaticOrder, PG8_ALIGN, PG8_SP2>(F.lds + RING_OFF, g, S, E); } SEAM(7 + 2 * half);
        if (IN(8 + 2 * half)) { conv_half(F, half); } SEAM(8 + 2 * half);
    }
    if (IN(11)) { pg8::Gemm g{ACT, WDT, T, DM, FF}; pg8::StaticOrder S; S.init(T, DM, F.G, cid); pg8::EpiOut E{X1B, F.out, SS3};
        pg8::gemm_phase<pg8::EpiOut, pg8::StaticOrder, PG8_ALIGN, PG8_SP2>(F.lds + RING_OFF, g, S, E); } SEAM(11);
    if (IN(12)) { final_norm(F); }
#undef IN
#undef SEAM
}

extern "C" void kernel_launch(void* const* d_in, const int* in_sizes, int n_in, void* d_out, int out_size, void* d_ws, size_t ws_size, hipStream_t stream) {
    static int grid = 0;
    if (grid == 0) {
        if (n_in != 21 || in_sizes[0] != T * DM || out_size != T * DM || ws_size < WS_END) { fprintf(stderr, "kernel_launch: unexpected shapes (n_in %d, in0 %d, out %d, ws %zu)\n", n_in, n_in > 0 ? in_sizes[0] : -1, out_size, ws_size); grid = -1; return; }
        int dev = 0, cus = 0;
        if (hipGetDevice(&dev) != hipSuccess || hipDeviceGetAttribute(&cus, hipDeviceAttributeMultiprocessorCount, dev) != hipSuccess) { grid = -1; return; }
        if (hipFuncSetAttribute((const void*)hymba_fwd, hipFuncAttributeMaxDynamicSharedMemorySize, LDS_BYTES) != hipSuccess) { fprintf(stderr, "kernel_launch: hipFuncSetAttribute failed\n"); grid = -1; return; }
        (void)hipGetLastError();
        grid = 256; if (cus != 256) fprintf(stderr, "kernel_launch: device reports %d CUs; built for 256\n", cus);
    }
    if (grid < 0) return;
    hipMemsetAsync((char*)d_ws + WS_CTL, 0, CTL_ZERO_BYTES, stream);
    Args a{};
    for (int i = 0; i < 21; ++i) a.in[i] = (const float*)d_in[i];
    a.out = (float*)d_out; a.ws = (unsigned char*)d_ws;
#if MK_SINGLE
    a.ph_lo = 0; a.ph_hi = NPHASE;
    hipLaunchKernelGGL(hymba_fwd, dim3(grid), dim3(NWAVES * 64), LDS_BYTES, stream, a);
#else
    for (int p = 0; p < NPHASE; ++p) { a.ph_lo = p; a.ph_hi = p + 1; hipLaunchKernelGGL(hymba_fwd, dim3(grid), dim3(NWAVES * 64), LDS_BYTES, stream, a); }
#endif
}
```

```cpp
#include <hip/hip_runtime.h>
#include <cstdio>
#include <cstdint>

#define DI __device__ __forceinline__
#define LAS __attribute__((address_space(3)))
#define GAS __attribute__((address_space(1)))
typedef unsigned short bf16;
typedef short bf16x8 __attribute__((ext_vector_type(8)));
typedef float f32x4 __attribute__((ext_vector_type(4)));
typedef float f32x16 __attribute__((ext_vector_type(16)));
typedef unsigned u32x4 __attribute__((ext_vector_type(4)));
typedef unsigned u32x2 __attribute__((ext_vector_type(2)));
typedef float f32x2_t __attribute__((ext_vector_type(2)));
typedef __bf16 bf16x2_t __attribute__((ext_vector_type(2)));

#ifndef MK_SINGLE
#define MK_SINGLE 1
#endif
#ifndef PROBE_MASK
#define PROBE_MASK 0
#endif

constexpr int NB = 32, SEQ = 2048, DM = 1024, T = NB * SEQ;
constexpr int NMEM = 256, TM = NB * NMEM;
constexpr int N1 = 2304;
constexpr int C_Y = 0, C_Q = 512, C_K = 768, C_V = 1024, C_LG = 1536, C_SR = 1792;
constexpr int WIN_LD = 2064;
constexpr int FF = 2816, NUP = 2 * FF;
constexpr float EPS = 1e-6f;
constexpr float LOG2E = 1.4426950408889634f;
constexpr int NPHASE = 13;

constexpr size_t MiB = 1u << 20;
constexpr size_t WS_CTL = 0, CTL_ZERO_BYTES = 1 * MiB;
constexpr size_t WS_SS = 1 * MiB;
constexpr size_t WS_W1T = 2 * MiB, WS_WOT = 7 * MiB, WS_WQT = 9 * MiB, WS_WKT = 11 * MiB, WS_WVT = 13 * MiB, WS_WXOT = 15 * MiB, WS_WUT = 17 * MiB, WS_WDT = 28 * MiB;
constexpr size_t WS_MN = 34 * MiB, WS_KB = 50 * MiB, WS_VT = 66 * MiB;
constexpr size_t WS_X1B = 82 * MiB;
constexpr size_t WS_MIX = 210 * MiB;
constexpr size_t WS_H1 = 338 * MiB;
constexpr size_t WS_PROJ = 466 * MiB;
constexpr size_t WS_ACT = 210 * MiB;
constexpr size_t WS_UH = 562 * MiB;
constexpr size_t WS_END = 914 * MiB;

namespace pg8 {
constexpr int BM = 256, BK = 64, HALF = 128, HTB = HALF * BK * 2, STAGE_BYTES = 8 * HTB, NXCD = 8, WGM = 8;
__host__ __device__ __forceinline__ int lds_byte(int r, int c) { const int st = (r >> 4) * 2 + (c >> 5), rr = r & 15, cc = c & 31, ob = rr * 64 + cc * 2; return st * 1024 + (ob ^ (((ob >> 9) & 1) << 5)); }
__host__ __device__ __forceinline__ void stage_rc(int b, int& R, int& C) { const int st = b / 1024, sb = b % 1024, swz = sb ^ (((sb >> 9) & 1) << 5); R = (st >> 1) * 16 + swz / 64; C = (st & 1) * 32 + (swz % 64) / 2; }
__host__ __device__ __forceinline__ int perm32(int rho) { const int n = rho >> 4, i = rho & 15; return 8 * (i >> 2) + 4 * n + (i & 3); }
struct Unit { int pm, pn; };
struct Gemm { const bf16* A; const bf16* Bt; int M, N, K; };
struct StaticOrder {
    int nM, nN, nwg, G, c;
    __host__ __device__ void init(int M, int N, int G_, int c_) { nM = M / BM; nN = N / BM; nwg = nM * nN; G = G_; c = c_; }
    __host__ __device__ bool next(int i, Unit& u) const {
        const long L = (long)i * G + c; if (L >= nwg) return false;
        int wgid = (int)L; { const int q = nwg / NXCD, r = nwg % NXCD, xcd = wgid % NXCD, off = wgid / NXCD; wgid = (xcd < r ? xcd * (q + 1) : r * (q + 1) + (xcd - r) * q) + off; }
        const int nig = WGM * nN, gid = wgid / nig, fm = gid * WGM, gsz = (nM - fm) < WGM ? (nM - fm) : WGM;
        u.pm = fm + ((wgid % nig) % gsz); u.pn = (wgid % nig) / gsz; return true;
    }
    __device__ __forceinline__ void a_ready(const Unit&) const {}
    __device__ __forceinline__ void done(const Unit&) const {}
};

DI unsigned cvtpk(float lo, float hi) { f32x2_t v = {lo, hi}; bf16x2_t b = __builtin_convertvector(v, bf16x2_t); return __builtin_bit_cast(unsigned, b); }
DI float bflo(unsigned w) { return __uint_as_float(w << 16); }
DI float bfhi(unsigned w) { return __uint_as_float(w & 0xffff0000u); }


struct EpiG1 {
    static constexpr bool PERM = true, AFTER_DRAIN = false;
    bf16* O; const float* gkb;
    DI void operator()(const f32x4 (&acc)[2][2][4][2], const Unit& u, int wr, int wc, int fr, int fq) const {
        const int row0 = u.pm * BM + wr * 64 + fr, col0 = u.pn * BM + wc * 32 + 8 * fq;
        const int mode = (u.pn == 6) ? 1 : (u.pn >= 7 ? 2 : 0);
        f32x4 bv[2][2];
#pragma unroll
        for (int bj = 0; bj < 2; ++bj)
#pragma unroll
            for (int n = 0; n < 2; ++n) bv[bj][n] = (mode == 1) ? *(const f32x4*)(gkb + (col0 - C_LG) + bj * HALF + 4 * n) : (f32x4){0.f, 0.f, 0.f, 0.f};
#pragma unroll
        for (int ai = 0; ai < 2; ++ai)
#pragma unroll
            for (int m = 0; m < 4; ++m) { bf16* rowp = O + (size_t)(row0 + ai * HALF + m * 16) * N1 + col0;
#pragma unroll
                for (int bj = 0; bj < 2; ++bj) { f32x4 v0 = acc[ai][bj][m][0], v1 = acc[ai][bj][m][1];
                    if (mode == 1) {
                        v0 = v0 + bv[bj][0]; v1 = v1 + bv[bj][1];
#pragma unroll
                        for (int j = 0; j < 4; ++j) {
                            { const float z = v0[j]; v0[j] = (fminf(z, 0.f) - __logf(1.f + __expf(-fabsf(z)))) * 0.0625f; }
                            { const float z = v1[j]; v1[j] = (fminf(z, 0.f) - __logf(1.f + __expf(-fabsf(z)))) * 0.0625f; } }
                    } else if (mode == 2) {
#pragma unroll
                        for (int j = 0; j < 4; ++j) {
                            { const float z = v0[j]; v0[j] = z * __builtin_amdgcn_rcpf(1.f + __expf(-z)); }
                            { const float z = v1[j]; v1[j] = z * __builtin_amdgcn_rcpf(1.f + __expf(-z)); } }
                    }
                    u32x4 w; w.x = cvtpk(v0[0], v0[1]); w.y = cvtpk(v0[2], v0[3]); w.z = cvtpk(v1[0], v1[1]); w.w = cvtpk(v1[2], v1[3]);
                    *(u32x4*)(rowp + bj * HALF) = w; } }
    }
};
template <bool ROWSCALE> struct EpiBf16 {
    static constexpr bool PERM = true, AFTER_DRAIN = false;
    bf16* O; int ldc; const float* ss; float cs;
    DI void operator()(const f32x4 (&acc)[2][2][4][2], const Unit& u, int wr, int wc, int fr, int fq) const {
        const int row0 = u.pm * BM + wr * 64 + fr, col0 = u.pn * BM + wc * 32 + 8 * fq;
#pragma unroll
        for (int ai = 0; ai < 2; ++ai)
#pragma unroll
            for (int m = 0; m < 4; ++m) { const int row = row0 + ai * HALF + m * 16; bf16* rowp = O + (size_t)row * ldc + col0;
                float sc = 1.f; if (ROWSCALE) sc = rsqrtf(ss[row] * (1.f / DM) + EPS) * cs;
#pragma unroll
                for (int bj = 0; bj < 2; ++bj) { const f32x4 v0 = acc[ai][bj][m][0] * sc, v1 = acc[ai][bj][m][1] * sc;
                    u32x4 w; w.x = cvtpk(v0[0], v0[1]); w.y = cvtpk(v0[2], v0[3]); w.z = cvtpk(v1[0], v1[1]); w.w = cvtpk(v1[2], v1[3]);
                    *(u32x4*)(rowp + bj * HALF) = w; } }
    }
};
template <bool RESF32> struct EpiRes {
    static constexpr bool PERM = true, AFTER_DRAIN = false;
    const void* res; bf16* O; float* ss;
    DI void operator()(const f32x4 (&acc)[2][2][4][2], const Unit& u, int wr, int wc, int fr, int fq) const {
        const int row0 = u.pm * BM + wr * 64 + fr, col0 = u.pn * BM + wc * 32 + 8 * fq;
#pragma unroll
        for (int ai = 0; ai < 2; ++ai)
#pragma unroll
            for (int m = 0; m < 4; ++m) { const int row = row0 + ai * HALF + m * 16; const size_t off = (size_t)row * DM + col0; float s = 0.f;
#pragma unroll
                for (int bj = 0; bj < 2; ++bj) { f32x4 r0, r1;
                    if (RESF32) { const float* rp = (const float*)res + off + bj * HALF; r0 = *(const f32x4*)rp; r1 = *(const f32x4*)(rp + 4); }
                    else { const u32x4 rw = *(const u32x4*)((const bf16*)res + off + bj * HALF); r0 = (f32x4){bflo(rw.x), bfhi(rw.x), bflo(rw.y), bfhi(rw.y)}; r1 = (f32x4){bflo(rw.z), bfhi(rw.z), bflo(rw.w), bfhi(rw.w)}; }
                    const f32x4 v0 = acc[ai][bj][m][0] + r0, v1 = acc[ai][bj][m][1] + r1;
                    s += (v0[0] * v0[0] + v0[1] * v0[1]) + (v0[2] * v0[2] + v0[3] * v0[3]) + (v1[0] * v1[0] + v1[1] * v1[1]) + (v1[2] * v1[2] + v1[3] * v1[3]);
                    u32x4 w; w.x = cvtpk(v0[0], v0[1]); w.y = cvtpk(v0[2], v0[3]); w.z = cvtpk(v1[0], v1[1]); w.w = cvtpk(v1[2], v1[3]);
                    *(u32x4*)(O + off + bj * HALF) = w; }
                s += __shfl_xor(s, 16); s += __shfl_xor(s, 32);
                if (fq == 0) atomicAdd(ss + row, s); }
    }
};
struct EpiOut {
    static constexpr bool PERM = true, AFTER_DRAIN = false;
    const bf16* res; float* O; float* ss;
    DI void operator()(const f32x4 (&acc)[2][2][4][2], const Unit& u, int wr, int wc, int fr, int fq) const {
        const int row0 = u.pm * BM + wr * 64 + fr, col0 = u.pn * BM + wc * 32 + 8 * fq;
#pragma unroll
        for (int ai = 0; ai < 2; ++ai)
#pragma unroll
            for (int m = 0; m < 4; ++m) { const int row = row0 + ai * HALF + m * 16; const size_t off = (size_t)row * DM + col0; float s = 0.f;
#pragma unroll
                for (int bj = 0; bj < 2; ++bj) {
                    const u32x4 rw = *(const u32x4*)(res + off + bj * HALF);
                    const f32x4 r0 = (f32x4){bflo(rw.x), bfhi(rw.x), bflo(rw.y), bfhi(rw.y)}, r1 = (f32x4){bflo(rw.z), bfhi(rw.z), bflo(rw.w), bfhi(rw.w)};
                    const f32x4 v0 = acc[ai][bj][m][0] + r0, v1 = acc[ai][bj][m][1] + r1;
                    s += (v0[0] * v0[0] + v0[1] * v0[1]) + (v0[2] * v0[2] + v0[3] * v0[3]) + (v1[0] * v1[0] + v1[1] * v1[1]) + (v1[2] * v1[2] + v1[3] * v1[3]);
                    *(f32x4*)(O + off + bj * HALF) = v0; *(f32x4*)(O + off + bj * HALF + 4) = v1; }
                s += __shfl_xor(s, 16); s += __shfl_xor(s, 32);
                if (fq == 0) atomicAdd(ss + row, s); }
    }
};

template <class Epi, class Sched, bool ALIGN_EPI = false, bool SP2 = false>
__device__ __forceinline__ void gemm_phase(LAS unsigned char* lds, const Gemm g, const Sched& S, const Epi& E) {
    const int tid = threadIdx.x, wid = __builtin_amdgcn_readfirstlane(tid >> 6), lane = tid & 63, wr = wid >> 2, wc = wid & 3, fr = lane & 15, fq = lane >> 4;
    const int K = g.K, nt = K / BK;
    unsigned voffA[2], voffB[2];
#pragma unroll
    for (int i = 0; i < 2; ++i) { int R, C; stage_rc(tid * 16 + i * 8192, R, C); const int Rb = Epi::PERM ? ((R & ~31) + perm32(R & 31)) : R;
        voffA[i] = (unsigned)(R * K + C) * 2u; voffB[i] = (unsigned)(Rb * K + C) * 2u; }
    const size_t kstep = (size_t)(BK * 2);
    const size_t hstep = (size_t)HALF * K * 2;
    const size_t tstep = 2 * hstep;
    const unsigned ldsw = (unsigned)wid * 1024u;
    const int aoff = lds_byte(wr * 64 + fr, fq * 8), boff = lds_byte(wc * 32 + fr, fq * 8);
#define PG8_SA(b, h) (((b) * 2 + (h)) * HTB)
#define PG8_SB(b, h) ((4 + (b) * 2 + (h)) * HTB)
#define PG8_STAGE(bufoff, gbase, voff) do { _Pragma("unroll") for (int _i = 0; _i < 2; ++_i) \
        __builtin_amdgcn_global_load_lds((const unsigned*)((const char*)(gbase) + (voff)[_i]), (LAS unsigned*)(lds + (bufoff) + ldsw + _i * 8192), 16, 0, 0); } while (0)
#define PG8_LDA(dst, b, h) do { _Pragma("unroll") for (int m = 0; m < 4; ++m) _Pragma("unroll") for (int k = 0; k < 2; ++k) dst[m][k] = *(const LAS bf16x8*)(lds + PG8_SA(b, h) + aoff + m * 2048 + k * 1024); } while (0)
#define PG8_LDB(dst, b, h) do { _Pragma("unroll") for (int n = 0; n < 2; ++n) _Pragma("unroll") for (int k = 0; k < 2; ++k) dst[n][k] = *(const LAS bf16x8*)(lds + PG8_SB(b, h) + boff + n * 2048 + k * 1024); } while (0)
#define PG8_MMA(ai, bj, At, Bt) do { __builtin_amdgcn_s_setprio(1); _Pragma("unroll") for (int m = 0; m < 4; ++m) _Pragma("unroll") for (int n = 0; n < 2; ++n) _Pragma("unroll") for (int k = 0; k < 2; ++k) \
        acc[ai][bj][m][n] = __builtin_amdgcn_mfma_f32_16x16x32_bf16(Bt[n][k], At[m][k], acc[ai][bj][m][n], 0, 0, 0); __builtin_amdgcn_s_setprio(0); } while (0)
#define PG8_WAIT_V(n) asm volatile("s_waitcnt vmcnt(" #n ")" ::: "memory")
#define PG8_WAIT_L(n) asm volatile("s_waitcnt lgkmcnt(" #n ")" ::: "memory")
#define PG8_BAR __builtin_amdgcn_s_barrier()
#define PG8_SCHED __builtin_amdgcn_sched_barrier(0)
    Unit cur, nxt; int ui = 0;
    if (!S.next(0, cur)) return;
    f32x4 acc[2][2][4][2];
#pragma unroll
    for (int a = 0; a < 2; ++a)
#pragma unroll
        for (int b = 0; b < 2; ++b)
#pragma unroll
            for (int m = 0; m < 4; ++m)
#pragma unroll
                for (int n = 0; n < 2; ++n) acc[a][b][m][n] = (f32x4){0.f, 0.f, 0.f, 0.f};
    bf16x8 At[4][2], B0[2][2], B1[2][2];
    const char* cA = (const char*)g.A + (size_t)cur.pm * tstep; const char* cB = (const char*)g.Bt + (size_t)cur.pn * tstep;
    S.a_ready(cur);
    if constexpr (SP2) {
        PG8_STAGE(PG8_SB(0, 0), cB, voffB); PG8_STAGE(PG8_SB(0, 1), cB + hstep, voffB); PG8_STAGE(PG8_SA(0, 0), cA, voffA); PG8_STAGE(PG8_SA(0, 1), cA + hstep, voffA);
        if (wr == 1) PG8_BAR;
        PG8_WAIT_V(2); PG8_BAR;
        PG8_STAGE(PG8_SB(1, 0), cB + kstep, voffB); PG8_STAGE(PG8_SA(1, 0), cA + kstep, voffA); PG8_STAGE(PG8_SB(1, 1), cB + hstep + kstep, voffB);
        PG8_WAIT_V(6); PG8_BAR;
    } else {
        PG8_STAGE(PG8_SB(0, 0), cB, voffB); PG8_STAGE(PG8_SA(0, 0), cA, voffA); PG8_STAGE(PG8_SB(0, 1), cB + hstep, voffB); PG8_STAGE(PG8_SA(0, 1), cA + hstep, voffA);
        if (wr == 1) PG8_BAR;
        PG8_WAIT_V(4); PG8_BAR;
        PG8_STAGE(PG8_SB(1, 0), cB + kstep, voffB); PG8_STAGE(PG8_SA(1, 0), cA + kstep, voffA); PG8_STAGE(PG8_SB(1, 1), cB + hstep + kstep, voffB);
        PG8_WAIT_V(6); PG8_BAR;
    }
    for (;;) {
        const bool has_next = S.next(ui + 1, nxt);
        const char* nA = has_next ? (const char*)g.A + (size_t)nxt.pm * tstep : cA; const char* nB = has_next ? (const char*)g.Bt + (size_t)nxt.pn * tstep : cB;
        for (int t = 0; t < nt; t += 2) {
            const bool last = (t == nt - 2);
            const char* a1 = cA + (size_t)(t + 1) * kstep;
            const char* a2 = last ? nA : cA + (size_t)(t + 2) * kstep; const char* b2 = last ? nB : cB + (size_t)(t + 2) * kstep;
            const char* a3 = a2 + kstep; const char* b3 = b2 + kstep;
            if (last && has_next) S.a_ready(nxt);
            if constexpr (SP2) {
            PG8_LDB(B0, 0, 0); PG8_LDB(B1, 0, 1); PG8_SCHED; PG8_LDA(At, 0, 0); PG8_STAGE(PG8_SA(1, 1), a1 + hstep, voffA);
            PG8_WAIT_V(8); PG8_WAIT_L(0); PG8_BAR; PG8_MMA(0, 0, At, B0); PG8_MMA(0, 1, At, B1); PG8_BAR; PG8_SCHED;
            PG8_LDA(At, 0, 1); PG8_STAGE(PG8_SB(0, 0), b2, voffB); PG8_STAGE(PG8_SB(0, 1), b2 + hstep, voffB); PG8_STAGE(PG8_SA(0, 0), a2, voffA);
            PG8_WAIT_V(8); PG8_WAIT_L(0); PG8_BAR; PG8_MMA(1, 0, At, B0); PG8_MMA(1, 1, At, B1); PG8_BAR; PG8_SCHED;
            PG8_LDB(B0, 1, 0); PG8_LDB(B1, 1, 1); PG8_SCHED; PG8_LDA(At, 1, 0); PG8_STAGE(PG8_SA(0, 1), a2 + hstep, voffA);
            PG8_WAIT_V(8); PG8_WAIT_L(0); PG8_BAR; PG8_MMA(0, 0, At, B0); PG8_MMA(0, 1, At, B1); PG8_BAR; PG8_SCHED;
            PG8_LDA(At, 1, 1); PG8_STAGE(PG8_SB(1, 0), b3, voffB); PG8_STAGE(PG8_SB(1, 1), b3 + hstep, voffB); PG8_STAGE(PG8_SA(1, 0), a3, voffA);
            PG8_WAIT_V(8); PG8_WAIT_L(0); PG8_BAR; PG8_MMA(1, 0, At, B0); PG8_MMA(1, 1, At, B1); PG8_BAR; PG8_SCHED;
            } else {
            PG8_LDB(B0, 0, 0); PG8_SCHED; PG8_LDA(At, 0, 0); PG8_STAGE(PG8_SA(1, 1), a1 + hstep, voffA);
            PG8_WAIT_L(8); PG8_BAR; PG8_WAIT_L(0); PG8_MMA(0, 0, At, B0); PG8_BAR; PG8_SCHED;
            PG8_LDB(B1, 0, 1); PG8_STAGE(PG8_SB(0, 0), b2, voffB);
            PG8_BAR; PG8_WAIT_L(0); PG8_MMA(0, 1, At, B1); PG8_BAR;
            PG8_LDA(At, 0, 1); PG8_STAGE(PG8_SA(0, 0), a2, voffA);
            PG8_BAR; PG8_WAIT_L(0); PG8_MMA(1, 0, At, B0); PG8_BAR; PG8_SCHED;
            PG8_STAGE(PG8_SB(0, 1), b2 + hstep, voffB);
            PG8_WAIT_V(6); PG8_BAR; PG8_MMA(1, 1, At, B1); PG8_BAR;
            PG8_LDB(B0, 1, 0); PG8_SCHED; PG8_LDA(At, 1, 0); PG8_STAGE(PG8_SA(0, 1), a2 + hstep, voffA);
            PG8_WAIT_L(8); PG8_BAR; PG8_WAIT_L(0); PG8_MMA(0, 0, At, B0); PG8_BAR; PG8_SCHED;
            PG8_LDB(B1, 1, 1); PG8_STAGE(PG8_SB(1, 0), b3, voffB);
            PG8_BAR; PG8_WAIT_L(0); PG8_MMA(0, 1, At, B1); PG8_BAR;
            PG8_LDA(At, 1, 1); PG8_STAGE(PG8_SA(1, 0), a3, voffA);
            PG8_BAR; PG8_WAIT_L(0); PG8_MMA(1, 0, At, B0); PG8_BAR; PG8_SCHED;
            PG8_STAGE(PG8_SB(1, 1), b3 + hstep, voffB);
            PG8_WAIT_V(6); PG8_BAR; PG8_MMA(1, 1, At, B1); PG8_BAR;
            }
        }
        if constexpr (ALIGN_EPI) { if (wr == 0) PG8_BAR; }
        if constexpr (!Epi::AFTER_DRAIN) { E(acc, cur, wr, wc, fr, fq); S.done(cur); }
        if (!has_next) break;
#pragma unroll
        for (int a = 0; a < 2; ++a)
#pragma unroll
            for (int b = 0; b < 2; ++b)
#pragma unroll
                for (int m = 0; m < 4; ++m)
#pragma unroll
                    for (int n = 0; n < 2; ++n) acc[a][b][m][n] = (f32x4){0.f, 0.f, 0.f, 0.f};
        cur = nxt; cA = nA; cB = nB; ++ui;
        if constexpr (ALIGN_EPI) { if (wr == 1) PG8_BAR; }
    }
    PG8_WAIT_V(0);
    if constexpr (!ALIGN_EPI) { if (wr == 0) PG8_BAR; }
    PG8_BAR;
#undef PG8_SA
#undef PG8_SB
#undef PG8_STAGE
#undef PG8_LDA
#undef PG8_LDB
#undef PG8_MMA
#undef PG8_WAIT_V
#undef PG8_WAIT_L
#undef PG8_BAR
#undef PG8_SCHED
}
}
using pg8::cvtpk; using pg8::bflo; using pg8::bfhi;

#ifndef PG8_SP2
#define PG8_SP2 true
#endif
#ifndef PG8_ALIGN
#define PG8_ALIGN true
#endif

constexpr int RING_OFF = 0, RING_BYTES = 131072;
constexpr int LDS_BYTES = 147456;
constexpr int LDSCTL_OFF = LDS_BYTES - 1024, MISC_OFF = LDSCTL_OFF + 320;
constexpr int NWAVES = 8;

typedef GAS unsigned gu32;
#define RLX_AGENT __ATOMIC_RELAXED, __HIP_MEMORY_SCOPE_AGENT
#define LDS_WAIT() asm volatile("s_waitcnt lgkmcnt(0)" ::: "memory")
#define VM_WAIT() asm volatile("s_waitcnt vmcnt(0)" ::: "memory")
DI unsigned f2bf(float f) { unsigned u = __builtin_bit_cast(unsigned, f); return (u + 0x7fffu + ((u >> 16) & 1u)) >> 16; }
DI unsigned pk2(float lo, float hi) { return f2bf(lo) | (f2bf(hi) << 16); }
DI float bf2f(bf16 v) { return __uint_as_float(((unsigned)v) << 16); }
DI float fexp(float x) { return __builtin_amdgcn_exp2f(x * LOG2E); }

#define XB_TMO      128
#define XB_XCNT(j)  (256  + 64 * (j))
#define XB_XSUB(j)  (1280 + 64 * (j))
#define XB_XGEN(j)  (2304 + 64 * (j))
#define XB_TOP      3328
#define XB_TOPGEN   3392
#define XCD_BAR_WORDS 3456
#define XB_SPIN_CAP (1u << 18)
constexpr int CW_BAR = 4096;
DI unsigned xb_ld(unsigned* p)              { return __hip_atomic_load(p, __ATOMIC_RELAXED, __HIP_MEMORY_SCOPE_AGENT); }
DI unsigned xb_add(unsigned* p, unsigned v) { return __hip_atomic_fetch_add(p, v, __ATOMIC_RELAXED, __HIP_MEMORY_SCOPE_AGENT); }
DI unsigned xb_xcc_id() { return (unsigned)__builtin_amdgcn_s_getreg((3 << 11) | 20) & 0xFu; }
#define XB_SPIN(cond, bar) do { unsigned _sp = 0; while (cond) { __builtin_amdgcn_s_sleep(1); \
    if ((++_sp & 255u) == 0u) { if (xb_ld(&(bar)[XB_TMO])) break; if (_sp > XB_SPIN_CAP) { atomicAdd(&(bar)[XB_TMO], 1u); break; } } } } while (0)
struct XcdBarrier { unsigned* bar; unsigned x; volatile LAS unsigned* st; };
DI XcdBarrier xcd_barrier_post(unsigned* bar, volatile LAS unsigned* st) {
    XcdBarrier b; b.bar = bar; b.x = xb_xcc_id(); b.st = st;
    if (threadIdx.x == 0) (void)xb_add(&bar[XB_XCNT(b.x)], 1u);
    return b;
}
DI void xcd_barrier_complete(unsigned* bar, unsigned x, unsigned& nloc, unsigned& nx) {
    const unsigned G = gridDim.x * gridDim.y * gridDim.z;
    unsigned sum, cnt, mine, sp = 0u;
    for (;;) {
        sum = 0u; cnt = 0u; mine = 0u;
#pragma unroll
        for (unsigned j = 0; j < 16; ++j) { const unsigned c = xb_ld(&bar[XB_XCNT(j)]); sum += c; cnt += (c > 0u) ? 1u : 0u; mine = (j == x) ? c : mine; }
        if (sum == G) break;
        __builtin_amdgcn_s_sleep(1);
        if ((++sp & 255u) == 0u) { if (xb_ld(&bar[XB_TMO])) break; if (sp > XB_SPIN_CAP) { atomicAdd(&bar[XB_TMO], 1u); break; } }
    }
    nloc = mine > 0u ? mine : 1u; nx = cnt > 0u ? cnt : 1u;
}
DI void xcd_barrier(const XcdBarrier& b) {
    asm volatile("s_waitcnt vmcnt(0)" ::: "memory");
    __syncthreads();
    if (threadIdx.x == 0) {
        unsigned* bar = b.bar;
        __builtin_amdgcn_s_waitcnt(0);
        unsigned nloc = b.st[0], nx = b.st[1];
        if (nloc == 0u) { xcd_barrier_complete(bar, b.x, nloc, nx); b.st[0] = nloc; b.st[1] = nx; }
        const unsigned old = xb_add(&bar[XB_XSUB(b.x)], 1u);
        const unsigned gen = old / nloc;
        if (old + 1u == (gen + 1u) * nloc) {
            __builtin_amdgcn_fence(__ATOMIC_RELEASE, "agent");
            asm volatile("s_waitcnt vmcnt(0)" ::: "memory");
            const unsigned og = xb_add(&bar[XB_TOP], 1u);
            const unsigned tg = og / nx;
            if (og + 1u == (tg + 1u) * nx) xb_add(&bar[XB_TOPGEN], 1u);
            else XB_SPIN(xb_ld(&bar[XB_TOPGEN]) == tg, bar);
            __builtin_amdgcn_fence(__ATOMIC_ACQUIRE, "agent");
            xb_add(&bar[XB_XGEN(b.x)], 1u);
            asm volatile("s_waitcnt vmcnt(0)" ::: "memory");
        } else {
            XB_SPIN(xb_ld(&bar[XB_XGEN(b.x)]) == gen, bar);
            __builtin_amdgcn_fence(__ATOMIC_ACQUIRE, "agent");
            asm volatile("s_waitcnt vmcnt(0)" ::: "memory");
        }
    }
    __syncthreads();
}

struct Args { const float* in[21]; float* out; unsigned char* ws; int ph_lo, ph_hi; };
struct Frame {
    LAS unsigned char* lds;
    int tid, lane, wave, vcu, G;
    const float* in[21]; float* out; unsigned char* ws;
};
DI float wave_sum(float v) {
#pragma unroll
    for (int o = 1; o < 64; o <<= 1) v += __shfl_xor(v, o);
    return v;
}

template <class F> DI void wt_item(F val, int K, bf16* WT, int nblk, LAS float* scr, int item, int lane) {
    const int kb = item / nblk, nb = item % nblk, k0 = 64 * kb, n0 = 32 * nb;
#pragma unroll 4
    for (int i = 0; i < 32; ++i) { const int kk = 2 * i + (lane >> 5); scr[kk * 33 + (lane & 31)] = val(k0 + kk, n0 + (lane & 31)); }
    LDS_WAIT(); asm volatile("" ::: "memory");
    const int c = lane & 7;
#pragma unroll
    for (int j = 0; j < 4; ++j) { const int n = (lane >> 3) + 8 * j; const LAS float* s = scr + (8 * c) * 33 + n;
        u32x4 o; o.x = pk2(s[0 * 33], s[1 * 33]); o.y = pk2(s[2 * 33], s[3 * 33]); o.z = pk2(s[4 * 33], s[5 * 33]); o.w = pk2(s[6 * 33], s[7 * 33]);
        *(u32x4*)(WT + (size_t)(n0 + n) * K + k0 + 8 * c) = o; }
    LDS_WAIT(); asm volatile("" ::: "memory");
}
DI void norm_row_to_bf16(int lane, const float* xrow, const f32x4 (&w)[4], bf16* orow) {
    const f32x4* xr = (const f32x4*)xrow + lane;
    f32x4 v[4]; float s = 0.f;
#pragma unroll
    for (int j = 0; j < 4; ++j) { v[j] = xr[64 * j]; s += (v[j].x * v[j].x + v[j].y * v[j].y) + (v[j].z * v[j].z + v[j].w * v[j].w); }
    const float rstd = rsqrtf(wave_sum(s) * (1.f / DM) + EPS);
    u32x2* o8 = (u32x2*)orow + lane;
#pragma unroll
    for (int j = 0; j < 4; ++j) { u32x2 o; o.x = cvtpk(v[j].x * rstd * w[j].x, v[j].y * rstd * w[j].y); o.y = cvtpk(v[j].z * rstd * w[j].z, v[j].w * rstd * w[j].w); o8[64 * j] = o; }
}
DI void p0_prologue(Frame& F) {
    LAS float* scr = (LAS float*)(F.lds + RING_OFF + F.wave * 16384);
    const int gw = F.vcu * NWAVES + F.wave, NGW = F.G * NWAVES, lane = F.lane;
    const float* win = F.in[3]; const float* pw = F.in[4]; const float* ps = F.in[5]; const float* gw2 = F.in[6];
    const float* wout = F.in[9]; const float* nxw = F.in[10]; const float* wq = F.in[12]; const float* wkv = F.in[13]; const float* wxo = F.in[14];
    const float* nfw = F.in[15]; const float* wup = F.in[16]; const float* wdn = F.in[19];
    bf16* W1T = (bf16*)(F.ws + WS_W1T); bf16* WOT = (bf16*)(F.ws + WS_WOT); bf16* WQT = (bf16*)(F.ws + WS_WQT); bf16* WKT = (bf16*)(F.ws + WS_WKT);
    bf16* WVT = (bf16*)(F.ws + WS_WVT); bf16* WXOT = (bf16*)(F.ws + WS_WXOT); bf16* WUT = (bf16*)(F.ws + WS_WUT); bf16* WDT = (bf16*)(F.ws + WS_WDT);
    constexpr int I_Y = 16 * 16, I_QKV = 16 * 32, I_G = 16 * 8, I_R = 16 * 16, I_SQ = 16 * 32, I_UP = 16 * 176, I_DN = 44 * 32;
    constexpr int NITEMS = I_Y + I_QKV + I_G + I_R + 5 * I_SQ + I_UP + I_DN;
    for (int it = gw; it < NITEMS; it += NGW) {
        int r = it;
        if (r < I_Y) {
            wt_item([&](int k, int n) { const int g = n >> 7, d = n & 127; const float* a = win + (size_t)k * WIN_LD + g * 128; const float* b = pw + (size_t)g * 16384 + d; float s = 0.f;
#pragma unroll 8
                for (int c = 0; c < 128; ++c) s += a[c] * b[c * 128];
                return s * ps[n]; }, DM, W1T, 16, scr, r, lane); continue; } r -= I_Y;
        if (r < I_QKV) {
            wt_item([&](int k, int n) { const float v = win[(size_t)k * WIN_LD + 512 + n]; return n < 256 ? v * 0.125f : v; }, DM, W1T + (size_t)C_Q * DM, 32, scr, r, lane); continue; } r -= I_QKV;
        if (r < I_G) {
            wt_item([&](int k, int n) { const float* a = win + (size_t)k * WIN_LD + 1536; float s = 0.f;
#pragma unroll
                for (int c = 0; c < 16; ++c) s += a[c] * gw2[c * 256 + n];
                return s; }, DM, W1T + (size_t)C_LG * DM, 8, scr, r, lane); continue; } r -= I_G;
        if (r < I_R) { wt_item([&](int k, int n) { return win[(size_t)k * WIN_LD + 1552 + n]; }, DM, W1T + (size_t)C_SR * DM, 16, scr, r, lane); continue; } r -= I_R;
        if (r < I_SQ) { wt_item([&](int k, int n) { return wout[(size_t)k * DM + n]; }, DM, WOT, 32, scr, r, lane); continue; } r -= I_SQ;
        if (r < I_SQ) { wt_item([&](int k, int n) { return wq[(size_t)k * DM + n] * nxw[k]; }, DM, WQT, 32, scr, r, lane); continue; } r -= I_SQ;
        if (r < I_SQ) { wt_item([&](int k, int n) { return wkv[(size_t)k * 2048 + n]; }, DM, WKT, 32, scr, r, lane); continue; } r -= I_SQ;
        if (r < I_SQ) { wt_item([&](int k, int n) { return wkv[(size_t)k * 2048 + 1024 + n]; }, DM, WVT, 32, scr, r, lane); continue; } r -= I_SQ;
        if (r < I_SQ) { wt_item([&](int k, int n) { return wxo[(size_t)k * DM + n]; }, DM, WXOT, 32, scr, r, lane); continue; } r -= I_SQ;
        if (r < I_UP) {
            wt_item([&](int k, int n) { const int pn = n >> 8, bj = (n >> 7) & 1, j = n & 127; return wup[(size_t)k * NUP + bj * FF + pn * 128 + j] * nfw[k]; }, DM, WUT, 176, scr, r, lane); continue; } r -= I_UP;
        wt_item([&](int k, int n) { return wdn[(size_t)k * DM + n]; }, FF, WDT, 32, scr, r, lane);
    }
    { float* ss = (float*)(F.ws + WS_SS); for (int i = (F.vcu * 512 + F.tid); i < 3 * T; i += F.G * 512) ss[i] = 0.f; }
    { const float* w = F.in[2]; f32x4 wv[4];
#pragma unroll
      for (int j = 0; j < 4; ++j) wv[j] = ((const f32x4*)w)[lane + 64 * j];
      bf16* H1 = (bf16*)(F.ws + WS_H1);
      for (int m = gw; m < T; m += NGW) norm_row_to_bf16(lane, F.in[0] + (size_t)m * DM, wv, H1 + (size_t)m * DM); }
    { const float* w = F.in[11]; f32x4 wv[4];
#pragma unroll
      for (int j = 0; j < 4; ++j) wv[j] = ((const f32x4*)w)[lane + 64 * j];
      bf16* MN = (bf16*)(F.ws + WS_MN);
      for (int m = gw; m < TM; m += NGW) norm_row_to_bf16(lane, F.in[1] + (size_t)m * DM, wv, MN + (size_t)m * DM); }
}

DI int crow(int reg, int h) { return (reg & 3) + 8 * (reg >> 2) + 4 * h; }
#define MFMA32(a, b, c) __builtin_amdgcn_mfma_f32_32x32x16_bf16((a), (b), (c), 0, 0, 0)
constexpr int GP = 144;
DI void mma_tile(f32x16& acc, LAS const unsigned char* A, LAS const unsigned char* B, int ksteps, int lane) {
    const int r = lane & 31, h = lane >> 5;
    LAS const unsigned char* ap = A + r * GP + 16 * h; LAS const unsigned char* bp = B + r * GP + 16 * h;
    for (int ks = 0; ks < ksteps; ++ks) { const bf16x8 a = *(const LAS bf16x8*)(ap + 32 * ks), b = *(const LAS bf16x8*)(bp + 32 * ks); acc = MFMA32(a, b, acc); }
}
DI void gla_item(Frame& F, int b, int h) {
    LAS unsigned char* L = F.lds;
    constexpr int QD = 0, KD = QD + 64 * GP, KET = KD + 64 * GP, VTL = KET + 64 * GP, SC = VTL + 128 * GP, STL = SC + 64 * GP, OL = STL + 128 * GP, OLP = 528,
                  DEC = OL + 64 * OLP, TOT = DEC + 256, GEND = TOT + 2048;
    static_assert(GEND <= RING_BYTES, "GLA LDS");
    const int tid = F.tid, lane = F.lane, wave = F.wave, r = lane & 31, hh = lane >> 5;
    const bf16* proj = (const bf16*)(F.ws + WS_PROJ); bf16* mix = (bf16*)(F.ws + WS_MIX); const float* gnw = F.in[8];
    for (int i = tid; i < 128 * GP / 4; i += 512) ((LAS unsigned*)(L + STL))[i] = 0u;
    f32x16 accS;
#pragma unroll
    for (int i = 0; i < 16; ++i) accS[i] = 0.f;
    const int it_o = wave >> 2, et_o = wave & 3, et_s = wave >> 1, dt_s = wave & 1;
    __syncthreads();
    for (int n = 0; n < SEQ / 64; ++n) {
        const size_t tok0 = (size_t)b * SEQ + 64 * n;
        const bf16* base = proj + tok0 * N1;
        {
            const int d = tid & 63, tg = tid >> 6;
            float lgv[8], qv[8], kv[8];
#pragma unroll
            for (int ii = 0; ii < 8; ++ii) { const bf16* rp = base + (size_t)(8 * tg + ii) * N1 + 64 * h + d; lgv[ii] = bf2f(rp[C_LG]); qv[ii] = bf2f(rp[C_Q]); kv[ii] = bf2f(rp[C_K]); }
            {
                const int e = tid & 127, tq = tid >> 7; unsigned pkv[8];
#pragma unroll
                for (int jj = 0; jj < 8; ++jj) { const bf16* rp = base + (size_t)(16 * tq + 2 * jj) * N1 + C_V + 128 * h + e; pkv[jj] = (unsigned)rp[0] | ((unsigned)rp[N1] << 16); }
                LAS u32x4* dst = (LAS u32x4*)(L + VTL + e * GP + tq * 32);
                dst[0] = (u32x4){pkv[0], pkv[1], pkv[2], pkv[3]}; dst[1] = (u32x4){pkv[4], pkv[5], pkv[6], pkv[7]};
            }
#pragma unroll
            for (int ii = 1; ii < 8; ++ii) lgv[ii] += lgv[ii - 1];
            ((LAS float*)(L + TOT))[tg * 64 + d] = lgv[7];
            __syncthreads();
            float pre = 0.f, tot = 0.f;
#pragma unroll
            for (int g = 0; g < 8; ++g) { const float t = ((LAS float*)(L + TOT))[g * 64 + d]; tot += t; pre += (g < tg) ? t : 0.f; }
            unsigned kep[4];
#pragma unroll
            for (int ii = 0; ii < 8; ii += 2) {
                const float G0 = pre + lgv[ii], G1 = pre + lgv[ii + 1];
                const float q0 = qv[ii] * fexp(G0), q1 = qv[ii + 1] * fexp(G1);
                const float k0 = kv[ii] * fexp(-G0), k1 = kv[ii + 1] * fexp(-G1);
                const float e0 = kv[ii] * fexp(tot - G0), e1 = kv[ii + 1] * fexp(tot - G1);
                *(LAS bf16*)(L + QD + (8 * tg + ii) * GP + 2 * d) = (bf16)f2bf(q0); *(LAS bf16*)(L + QD + (8 * tg + ii + 1) * GP + 2 * d) = (bf16)f2bf(q1);
                *(LAS bf16*)(L + KD + (8 * tg + ii) * GP + 2 * d) = (bf16)f2bf(k0); *(LAS bf16*)(L + KD + (8 * tg + ii + 1) * GP + 2 * d) = (bf16)f2bf(k1);
                kep[ii >> 1] = cvtpk(e0, e1);
            }
            *(LAS u32x4*)(L + KET + d * GP + tg * 16) = (u32x4){kep[0], kep[1], kep[2], kep[3]};
            if (tg == 0) ((LAS float*)(L + DEC))[d] = fexp(tot);
        }
        __syncthreads();
        f32x16 acc_o;
#pragma unroll
        for (int i = 0; i < 16; ++i) acc_o[i] = 0.f;
        if (wave < 3) {
            const int it = (wave >= 1) ? 1 : 0, jt = (wave == 2) ? 1 : 0;
            f32x16 sc;
#pragma unroll
            for (int i = 0; i < 16; ++i) sc[i] = 0.f;
            mma_tile(sc, L + QD + it * 32 * GP, L + KD + jt * 32 * GP, 4, lane);
#pragma unroll
            for (int reg = 0; reg < 16; ++reg) { const int i = 32 * it + crow(reg, hh), j = 32 * jt + r; const float v = (j <= i) ? sc[reg] : 0.f; *(LAS bf16*)(L + SC + i * GP + 2 * j) = (bf16)f2bf(v); }
        }
        mma_tile(acc_o, L + QD + it_o * 32 * GP, L + STL + et_o * 32 * GP, 4, lane);
        { const float dec = ((LAS float*)(L + DEC))[32 * dt_s + r];
#pragma unroll
          for (int i = 0; i < 16; ++i) accS[i] *= dec;
          mma_tile(accS, L + VTL + et_s * 32 * GP, L + KET + dt_s * 32 * GP, 4, lane); }
        __syncthreads();
        mma_tile(acc_o, L + SC + it_o * 32 * GP, L + VTL + et_o * 32 * GP, 2 * (it_o + 1), lane);
#pragma unroll
        for (int reg = 0; reg < 16; ++reg) {
            *(LAS bf16*)(L + STL + (32 * et_s + crow(reg, hh)) * GP + 2 * (32 * dt_s + r)) = (bf16)f2bf(accS[reg]);
            *(LAS float*)(L + OL + (32 * it_o + crow(reg, hh)) * OLP + 4 * (32 * et_o + r)) = acc_o[reg];
        }
        __syncthreads();
        {
            const int i = tid >> 3, eg = tid & 7; float o[16]; float s = 0.f;
#pragma unroll
            for (int q = 0; q < 4; ++q) { const f32x4 v = *(LAS const f32x4*)(L + OL + i * OLP + 64 * eg + 16 * q); o[4 * q] = v[0]; o[4 * q + 1] = v[1]; o[4 * q + 2] = v[2]; o[4 * q + 3] = v[3]; s += (v[0] * v[0] + v[1] * v[1]) + (v[2] * v[2] + v[3] * v[3]); }
            s += __shfl_xor(s, 1); s += __shfl_xor(s, 2); s += __shfl_xor(s, 4);
            const float rstd = rsqrtf(s * (1.f / 128.f) + EPS);
            const bf16* srp = base + (size_t)i * N1 + C_SR + 128 * h + 16 * eg;
            const u32x4 s0 = *(const u32x4*)srp, s1 = *(const u32x4*)(srp + 8);
            const unsigned sw[8] = {s0.x, s0.y, s0.z, s0.w, s1.x, s1.y, s1.z, s1.w};
            unsigned ow[8];
#pragma unroll
            for (int q = 0; q < 8; ++q) { const float g0 = gnw[16 * eg + 2 * q], g1 = gnw[16 * eg + 2 * q + 1]; ow[q] = cvtpk(o[2 * q] * rstd * g0 * bflo(sw[q]), o[2 * q + 1] * rstd * g1 * bfhi(sw[q])); }
            bf16* op = mix + (tok0 + i) * DM + 512 + 128 * h + 16 * eg;
            *(u32x4*)op = (u32x4){ow[0], ow[1], ow[2], ow[3]}; *(u32x4*)(op + 8) = (u32x4){ow[4], ow[5], ow[6], ow[7]};
        }
    }
}
DI void pool_item(Frame& F, int item) {
    const int lane = F.lane, b = item >> 5, blk = item & 31, c0 = 8 * lane, w = 2 << (lane >> 4);
    const bf16* proj = (const bf16*)(F.ws + WS_PROJ); bf16* mix = (bf16*)(F.ws + WS_MIX);
    const size_t seq0 = (size_t)b * SEQ; const int p0 = 64 * blk;
    float s[8];
#pragma unroll
    for (int j = 0; j < 8; ++j) s[j] = 0.f;
    for (int k = 15; k >= 1; --k) { const int p = p0 - k; if (k <= w - 1 && p >= 0) { const u32x4 v = *(const u32x4*)(proj + (seq0 + p) * N1 + c0);
        s[0] += bflo(v.x); s[1] += bfhi(v.x); s[2] += bflo(v.y); s[3] += bfhi(v.y); s[4] += bflo(v.z); s[5] += bfhi(v.z); s[6] += bflo(v.w); s[7] += bfhi(v.w); } }
    for (int t = 0; t < 64; ++t) {
        const int p = p0 + t; const u32x4 v = *(const u32x4*)(proj + (seq0 + p) * N1 + c0);
        const float y[8] = {bflo(v.x), bfhi(v.x), bflo(v.y), bfhi(v.y), bflo(v.z), bfhi(v.z), bflo(v.w), bfhi(v.w)};
        const float inv = 1.f / (float)((p + 1) < w ? (p + 1) : w);
        float o[8];
#pragma unroll
        for (int j = 0; j < 8; ++j) { s[j] += y[j]; o[j] = s[j] * inv - y[j]; }
        *(u32x4*)(mix + (seq0 + p) * DM + c0) = (u32x4){cvtpk(o[0], o[1]), cvtpk(o[2], o[3]), cvtpk(o[4], o[5]), cvtpk(o[6], o[7])};
        const int pd = p - w + 1;
        if (pd >= 0) { const u32x4 u = *(const u32x4*)(proj + (seq0 + pd) * N1 + c0);
            s[0] -= bflo(u.x); s[1] -= bfhi(u.x); s[2] -= bflo(u.y); s[3] -= bfhi(u.y); s[4] -= bflo(u.z); s[5] -= bfhi(u.z); s[6] -= bflo(u.w); s[7] -= bfhi(u.w); }
    }
}

constexpr int ATT_PP = 1056, ATT_LDS = 128 * ATT_PP;
DI int swap23(int r) { return (r & ~12) | ((r & 4) << 1) | ((r & 8) >> 1); }
DI void attn_fill(LAS unsigned char* L, const bf16* src, size_t pitch_elems, int wave, int lane) {
    const unsigned loff = (unsigned)((lane & 1) * pitch_elems * 2 + (lane >> 1) * 16);
#pragma unroll
    for (int i = 0; i < 16; ++i) { const int p = wave * 16 + i;
        __builtin_amdgcn_global_load_lds((const unsigned*)((const char*)(src + (size_t)(2 * p) * pitch_elems) + loff), (LAS unsigned*)(L + p * ATT_PP), 16, 0, 0); }
}
static_assert(ATT_LDS <= LDSCTL_OFF, "attention LDS image");
DI void attn_unit(Frame& F, int unit) {
    LAS unsigned char* L = F.lds;
    int lane_ = F.lane; asm volatile("" : "+v"(lane_));
    const int lane = lane_, wave = F.wave, r = lane & 31, hh = lane >> 5;
    const int qb = unit & 7, bh = unit >> 3, b = bh >> 2, h = bh & 3;
    const bf16* Q = (const bf16*)(F.ws + WS_H1); const bf16* KB = (const bf16*)(F.ws + WS_KB); const bf16* VT = (const bf16*)(F.ws + WS_VT); bf16* O = (bf16*)(F.ws + WS_MIX);
    const size_t t0 = (size_t)b * SEQ + 256 * qb + 32 * wave;
    attn_fill(L, KB + (size_t)b * NMEM * DM + 256 * h, DM, wave, lane);
    bf16x8 qf[16];
    { const bf16* qp = Q + (t0 + r) * DM + 256 * h + 8 * hh;
#pragma unroll
      for (int ks = 0; ks < 16; ++ks) qf[ks] = *(const bf16x8*)(qp + 16 * ks); }
    VM_WAIT(); __syncthreads();
    f32x16 sacc[8];
    { const int kr = swap23(r);
      LAS const unsigned char* kbase = L + (kr >> 1) * ATT_PP + (kr & 1) * 16 + 32 * hh;
#pragma unroll
      for (int kt = 0; kt < 8; ++kt) {
#pragma unroll
        for (int i = 0; i < 16; ++i) sacc[kt][i] = 0.f;
#pragma unroll
        for (int ks = 0; ks < 16; ++ks) { const bf16x8 kf = *(LAS const bf16x8*)(kbase + kt * 16 * ATT_PP + 64 * ks); sacc[kt] = MFMA32(kf, qf[ks], sacc[kt]); }
      } }
    __syncthreads();
    attn_fill(L, VT + (size_t)(256 * h) * TM + (size_t)b * NMEM, TM, wave, lane);
    float mx = sacc[0][0];
#pragma unroll
    for (int kt = 0; kt < 8; ++kt)
#pragma unroll
        for (int i = 0; i < 16; ++i) mx = fmaxf(mx, sacc[kt][i]);
    mx = fmaxf(mx, __shfl_xor(mx, 32));
    float sum = 0.f;
    bf16x8 pf[8][2];
#pragma unroll
    for (int kt = 0; kt < 8; ++kt) {
#pragma unroll
        for (int i = 0; i < 16; ++i) { const float pv = __builtin_amdgcn_exp2f(sacc[kt][i] - mx); sacc[kt][i] = pv; sum += pv; }
#pragma unroll
        for (int s2 = 0; s2 < 2; ++s2) { u32x4 pw; pw.x = cvtpk(sacc[kt][8 * s2], sacc[kt][8 * s2 + 1]); pw.y = cvtpk(sacc[kt][8 * s2 + 2], sacc[kt][8 * s2 + 3]); pw.z = cvtpk(sacc[kt][8 * s2 + 4], sacc[kt][8 * s2 + 5]); pw.w = cvtpk(sacc[kt][8 * s2 + 6], sacc[kt][8 * s2 + 7]);
            pf[kt][s2] = __builtin_bit_cast(bf16x8, pw); }
    }
    sum += __shfl_xor(sum, 32);
    const float inv = 1.f / sum;
    VM_WAIT(); __syncthreads();
    bf16* op = O + (t0 + r) * DM + 256 * h + 4 * hh;
    LAS const unsigned char* vbase = L + (r >> 1) * ATT_PP + (r & 1) * 16 + 32 * hh;
#pragma unroll 1
    for (int dt = 0; dt < 8; ++dt) {
        f32x16 oacc;
#pragma unroll
        for (int i = 0; i < 16; ++i) oacc[i] = 0.f;
#pragma unroll
        for (int kt = 0; kt < 8; ++kt)
#pragma unroll
            for (int s2 = 0; s2 < 2; ++s2) { const bf16x8 vf = *(LAS const bf16x8*)(vbase + dt * 16 * ATT_PP + 64 * (2 * kt + s2)); oacc = MFMA32(vf, pf[kt][s2], oacc); }
#pragma unroll
        for (int g = 0; g < 4; ++g) { u32x2 w; w.x = cvtpk(oacc[4 * g] * inv, oacc[4 * g + 1] * inv); w.y = cvtpk(oacc[4 * g + 2] * inv, oacc[4 * g + 3] * inv); *(u32x2*)(op + 32 * dt + 8 * g) = w; }
    }
    __syncthreads();
}

DI void conv_half(Frame& F, int half) {
    const bf16* U = (const bf16*)(F.ws + WS_UH); bf16* ACT = (bf16*)(F.ws + WS_ACT);
    const float* cw = F.in[17]; const float* cb = F.in[18];
    constexpr int RUN = 32, NCG = FF / 8, NITEM = (T / 2 / RUN) * NCG;
    for (int item = F.vcu * 512 + F.tid; item < NITEM; item += F.G * 512) {
        const int rr = item / NCG, cg = item - rr * NCG, ca = 8 * cg, pn = ca >> 7, j = ca & 127;
        const int ucol = 256 * pn + j;
        float wg[3][8], wv[3][8], bg[8], bv[8];
#pragma unroll
        for (int t = 0; t < 3; ++t)
#pragma unroll
            for (int q = 0; q < 8; ++q) { wg[t][q] = cw[t * NUP + ca + q]; wv[t][q] = cw[t * NUP + FF + ca + q]; }
#pragma unroll
        for (int q = 0; q < 8; ++q) { bg[q] = cb[ca + q]; bv[q] = cb[FF + ca + q]; }
        const int lr0 = rr * RUN;
        const int pos0 = (lr0 & (SEQ - 1));
        float g1[8], g2[8], v1[8], v2[8];
#pragma unroll
        for (int q = 0; q < 8; ++q) { g1[q] = g2[q] = v1[q] = v2[q] = 0.f; }
        if (pos0 >= 2) {
            const u32x4 a = *(const u32x4*)(U + (size_t)(lr0 - 2) * NUP + ucol), b = *(const u32x4*)(U + (size_t)(lr0 - 2) * NUP + ucol + 128);
            const u32x4 c = *(const u32x4*)(U + (size_t)(lr0 - 1) * NUP + ucol), d = *(const u32x4*)(U + (size_t)(lr0 - 1) * NUP + ucol + 128);
            const unsigned aw[4] = {a.x, a.y, a.z, a.w}, bw[4] = {b.x, b.y, b.z, b.w}, cw4[4] = {c.x, c.y, c.z, c.w}, dw[4] = {d.x, d.y, d.z, d.w};
#pragma unroll
            for (int q = 0; q < 4; ++q) { g2[2 * q] = bflo(aw[q]); g2[2 * q + 1] = bfhi(aw[q]); v2[2 * q] = bflo(bw[q]); v2[2 * q + 1] = bfhi(bw[q]);
                g1[2 * q] = bflo(cw4[q]); g1[2 * q + 1] = bfhi(cw4[q]); v1[2 * q] = bflo(dw[q]); v1[2 * q + 1] = bfhi(dw[q]); }
        }
        for (int t = 0; t < RUN; ++t) {
            const size_t lr = (size_t)(lr0 + t);
            const u32x4 a = *(const u32x4*)(U + lr * NUP + ucol), b = *(const u32x4*)(U + lr * NUP + ucol + 128);
            const unsigned aw[4] = {a.x, a.y, a.z, a.w}, bw[4] = {b.x, b.y, b.z, b.w};
            float g0[8], v0[8]; unsigned ow[4];
#pragma unroll
            for (int q = 0; q < 4; ++q) { g0[2 * q] = bflo(aw[q]); g0[2 * q + 1] = bfhi(aw[q]); v0[2 * q] = bflo(bw[q]); v0[2 * q + 1] = bfhi(bw[q]); }
            float o[8];
#pragma unroll
            for (int q = 0; q < 8; ++q) {
                const float gg = bg[q] + wg[0][q] * g2[q] + wg[1][q] * g1[q] + wg[2][q] * g0[q];
                const float vv = bv[q] + wv[0][q] * v2[q] + wv[1][q] * v1[q] + wv[2][q] * v0[q];
                o[q] = gg * __builtin_amdgcn_rcpf(1.f + __expf(-gg)) * vv;
                g2[q] = g1[q]; g1[q] = g0[q]; v2[q] = v1[q]; v1[q] = v0[q];
            }
#pragma unroll
            for (int q = 0; q < 4; ++q) ow[q] = cvtpk(o[2 * q], o[2 * q + 1]);
            *(u32x4*)(ACT + ((size_t)half * (T / 2) + lr) * FF + ca) = (u32x4){ow[0], ow[1], ow[2], ow[3]};
        }
    }
}

DI void final_norm(Frame& F) {
    const int gw = F.vcu * NWAVES + F.wave, NGW = F.G * NWAVES, lane = F.lane;
    const float* ss = (const float*)(F.ws + WS_SS) + 2 * T; const float* w = F.in[20];
    f32x4 wv[4];
#pragma unroll
    for (int j = 0; j < 4; ++j) wv[j] = ((const f32x4*)w)[lane + 64 * j];
    for (int m = gw; m < T; m += NGW) {
        const float rstd = rsqrtf(ss[m] * (1.f / DM) + EPS);
        f32x4* p = (f32x4*)(F.out + (size_t)m * DM) + lane;
#pragma unroll
        for (int j = 0; j < 4; ++j) { f32x4 v = p[64 * j]; v = v * rstd * wv[j]; p[64 * j] = v; }
    }
}

__global__ void __launch_bounds__(NWAVES * 64, 2) hymba_fwd(Args args) {
    extern __shared__ __attribute__((aligned(16))) unsigned char lds[];
    Frame F;
    F.lds = (LAS unsigned char*)lds;
    F.tid = threadIdx.x; F.lane = F.tid & 63; F.wave = __builtin_amdgcn_readfirstlane(F.tid >> 6);
    F.G = gridDim.x; { const int bx = blockIdx.x; F.vcu = (F.G % 8 == 0) ? (bx % 8) * (F.G / 8) + bx / 8 : bx; }
#pragma unroll
    for (int i = 0; i < 21; ++i) F.in[i] = args.in[i];
    F.out = args.out; F.ws = args.ws;
    volatile LAS unsigned* MISC = (volatile LAS unsigned*)(F.lds + MISC_OFF);
    for (int u = F.tid; u < (LDS_BYTES - LDSCTL_OFF) / 4; u += NWAVES * 64) ((LAS unsigned*)(F.lds + LDSCTL_OFF))[u] = 0u;
    __syncthreads();
    const int lo = args.ph_lo, hi = args.ph_hi;
    XcdBarrier bar; bar.bar = (unsigned*)(F.ws + WS_CTL) + CW_BAR; bar.x = 0; bar.st = nullptr;
    if (hi - lo > 1) bar = xcd_barrier_post((unsigned*)(F.ws + WS_CTL) + CW_BAR, MISC + 8);
#define IN(k) (lo <= (k) && (k) < hi)
    unsigned long long pr_acc = 0, pr_t0 = 0;
#define RT_NOW(t) asm volatile("s_memrealtime %0\n\ts_waitcnt lgkmcnt(0)" : "=s"(t) :: "memory")
#define PB(k) do { if ((PROBE_MASK >> (k)) & 1) { RT_NOW(pr_t0); } } while (0)
#define SEAM(k) do { if (IN(k) && IN((k) + 1)) xcd_barrier(bar); if ((PROBE_MASK >> (k)) & 1) { unsigned long long t1_; RT_NOW(t1_); pr_acc += t1_ - pr_t0; } } while (0)
    const int cid = (int)blockIdx.x;
    bf16* W1T = (bf16*)(F.ws + WS_W1T); bf16* WOT = (bf16*)(F.ws + WS_WOT); bf16* WQT = (bf16*)(F.ws + WS_WQT); bf16* WKT = (bf16*)(F.ws + WS_WKT);
    bf16* WVT = (bf16*)(F.ws + WS_WVT); bf16* WXOT = (bf16*)(F.ws + WS_WXOT); bf16* WUT = (bf16*)(F.ws + WS_WUT); bf16* WDT = (bf16*)(F.ws + WS_WDT);
    bf16* H1 = (bf16*)(F.ws + WS_H1); bf16* PROJ = (bf16*)(F.ws + WS_PROJ); bf16* MIX = (bf16*)(F.ws + WS_MIX); bf16* X1B = (bf16*)(F.ws + WS_X1B);
    bf16* MN = (bf16*)(F.ws + WS_MN); bf16* KB = (bf16*)(F.ws + WS_KB); bf16* VT = (bf16*)(F.ws + WS_VT); bf16* ACT = (bf16*)(F.ws + WS_ACT); bf16* UH = (bf16*)(F.ws + WS_UH);
    float* SS1 = (float*)(F.ws + WS_SS); float* SS2 = SS1 + T; float* SS3 = SS2 + T;

    PB(0); if (IN(0)) { p0_prologue(F); } SEAM(0);
    PB(1); if (IN(1)) {
        { pg8::Gemm g{H1, W1T, T, N1, DM}; pg8::StaticOrder S; S.init(T, N1, F.G, cid); pg8::EpiG1 E{PROJ, F.in[7]};
          pg8::gemm_phase<pg8::EpiG1, pg8::StaticOrder, PG8_ALIGN, PG8_SP2>(F.lds + RING_OFF, g, S, E); }
        { pg8::Gemm g{MN, WKT, TM, DM, DM}; pg8::StaticOrder S; S.init(TM, DM, F.G, cid); pg8::EpiBf16<false> E{KB, DM, nullptr, 1.f};
          pg8::gemm_phase<pg8::EpiBf16<false>, pg8::StaticOrder, PG8_ALIGN, PG8_SP2>(F.lds + RING_OFF, g, S, E); }
        { pg8::Gemm g{WVT, MN, DM, TM, DM}; pg8::StaticOrder S; S.init(DM, TM, F.G, (cid + F.G / 2) % F.G); pg8::EpiBf16<false> E{VT, TM, nullptr, 1.f};
          pg8::gemm_phase<pg8::EpiBf16<false>, pg8::StaticOrder, PG8_ALIGN, PG8_SP2>(F.lds + RING_OFF, g, S, E); }
    } SEAM(1);
    PB(2); if (IN(2)) {
        if (cid < 128) gla_item(F, cid >> 2, cid & 3);
        else { for (int item = (cid - 128) * NWAVES + F.wave; item < NB * (SEQ / 64); item += (F.G - 128) * NWAVES) pool_item(F, item); }
    } SEAM(2);
    PB(3); if (IN(3)) { pg8::Gemm g{MIX, WOT, T, DM, DM}; pg8::StaticOrder S; S.init(T, DM, F.G, cid); pg8::EpiRes<true> E{F.in[0], X1B, SS1};
        pg8::gemm_phase<pg8::EpiRes<true>, pg8::StaticOrder, PG8_ALIGN, PG8_SP2>(F.lds + RING_OFF, g, S, E); } SEAM(3);
    PB(4); if (IN(4)) { pg8::Gemm g{X1B, WQT, T, DM, DM}; pg8::StaticOrder S; S.init(T, DM, F.G, cid); pg8::EpiBf16<true> E{H1, DM, SS1, 0.0625f * LOG2E};
        pg8::gemm_phase<pg8::EpiBf16<true>, pg8::StaticOrder, PG8_ALIGN, PG8_SP2>(F.lds + RING_OFF, g, S, E); } SEAM(4);
    PB(5); if (IN(5)) { for (int unit = F.vcu * 4; unit < F.vcu * 4 + 4; ++unit) attn_unit(F, unit); } SEAM(5);
    PB(6); if (IN(6)) { pg8::Gemm g{MIX, WXOT, T, DM, DM}; pg8::StaticOrder S; S.init(T, DM, F.G, cid); pg8::EpiRes<false> E{X1B, X1B, SS2};
        pg8::gemm_phase<pg8::EpiRes<false>, pg8::StaticOrder, PG8_ALIGN, PG8_SP2>(F.lds + RING_OFF, g, S, E); } SEAM(6);
#pragma unroll 1
    for (int half = 0; half < 2; ++half) {
        PB(7 + 2 * half); if (IN(7 + 2 * half)) { pg8::Gemm g{X1B + (size_t)half * (T / 2) * DM, WUT, T / 2, NUP, DM}; pg8::StaticOrder S; S.init(T / 2, NUP, F.G, cid);
            pg8::EpiBf16<true> E{UH, NUP, SS2 + half * (T / 2), 1.f};
            pg8::gemm_phase<pg8::EpiBf16<true>, pg8::StaticOrder, PG8_ALIGN, PG8_SP2>(F.lds + RING_OFF, g, S, E); } SEAM(7 + 2 * half);
        PB(8 + 2 * half); if (IN(8 + 2 * half)) { conv_half(F, half); } SEAM(8 + 2 * half);
    }
    PB(11); if (IN(11)) { pg8::Gemm g{ACT, WDT, T, DM, FF}; pg8::StaticOrder S; S.init(T, DM, F.G, cid); pg8::EpiOut E{X1B, F.out, SS3};
        pg8::gemm_phase<pg8::EpiOut, pg8::StaticOrder, PG8_ALIGN, PG8_SP2>(F.lds + RING_OFF, g, S, E); } SEAM(11);
    PB(12); if (IN(12)) { final_norm(F); }
    if (PROBE_MASK) { if ((PROBE_MASK >> 12) & 1) { unsigned long long t1_; RT_NOW(t1_); pr_acc += t1_ - pr_t0; }
        if (blockIdx.x == 0 && F.tid == 0) { unsigned long long ta, tb; RT_NOW(ta); for (;;) { RT_NOW(tb); if (tb - ta >= pr_acc) break; __builtin_amdgcn_s_sleep(8); } } }
#undef IN
#undef SEAM
}

extern "C" void kernel_launch(void* const* d_in, const int* in_sizes, int n_in, void* d_out, int out_size, void* d_ws, size_t ws_size, hipStream_t stream) {
    static int grid = 0;
    if (grid == 0) {
        if (n_in != 21 || in_sizes[0] != T * DM || out_size != T * DM || ws_size < WS_END) { fprintf(stderr, "kernel_launch: unexpected shapes (n_in %d, in0 %d, out %d, ws %zu)\n", n_in, n_in > 0 ? in_sizes[0] : -1, out_size, ws_size); grid = -1; return; }
        int dev = 0, cus = 0;
        if (hipGetDevice(&dev) != hipSuccess || hipDeviceGetAttribute(&cus, hipDeviceAttributeMultiprocessorCount, dev) != hipSuccess) { grid = -1; return; }
        if (hipFuncSetAttribute((const void*)hymba_fwd, hipFuncAttributeMaxDynamicSharedMemorySize, LDS_BYTES) != hipSuccess) { fprintf(stderr, "kernel_launch: hipFuncSetAttribute failed\n"); grid = -1; return; }
        (void)hipGetLastError();
        grid = 256; if (cus != 256) fprintf(stderr, "kernel_launch: device reports %d CUs; built for 256\n", cus);
    }
    if (grid < 0) return;
    hipMemsetAsync((char*)d_ws + WS_CTL, 0, CTL_ZERO_BYTES, stream);
    Args a{};
    for (int i = 0; i < 21; ++i) a.in[i] = (const float*)d_in[i];
    a.out = (float*)d_out; a.ws = (unsigned char*)d_ws;
#if MK_SINGLE
    a.ph_lo = 0; a.ph_hi = NPHASE;
    hipLaunchKernelGGL(hymba_fwd, dim3(grid), dim3(NWAVES * 64), LDS_BYTES, stream, a);
#else
    for (int p = 0; p < NPHASE; ++p) { a.ph_lo = p; a.ph_hi = p + 1; hipLaunchKernelGGL(hymba_fwd, dim3(grid), dim3(NWAVES * 64), LDS_BYTES, stream, a); }
#endif
}
```

```cpp
#include <hip/hip_runtime.h>
#include <cstdio>
#include <cstdint>

#define DI __device__ __forceinline__
#define LAS __attribute__((address_space(3)))
#define GAS __attribute__((address_space(1)))
typedef unsigned short bf16;
typedef short bf16x8 __attribute__((ext_vector_type(8)));
typedef float f32x4 __attribute__((ext_vector_type(4)));
typedef float f32x16 __attribute__((ext_vector_type(16)));
typedef unsigned u32x4 __attribute__((ext_vector_type(4)));
typedef unsigned u32x2 __attribute__((ext_vector_type(2)));
typedef float f32x2_t __attribute__((ext_vector_type(2)));
typedef __bf16 bf16x2_t __attribute__((ext_vector_type(2)));

#ifndef MK_SINGLE
#define MK_SINGLE 1
#endif
#ifndef PROBE_MASK
#define PROBE_MASK 0
#endif

constexpr int NB = 32, SEQ = 2048, DM = 1024, T = NB * SEQ;
constexpr int NMEM = 256, TM = NB * NMEM;
constexpr int N1 = 2304;
constexpr int C_Y = 0, C_Q = 512, C_K = 768, C_V = 1024, C_LG = 1536, C_SR = 1792;
constexpr int WIN_LD = 2064;
constexpr int FF = 2816, NUP = 2 * FF;
constexpr float EPS = 1e-6f;
constexpr float LOG2E = 1.4426950408889634f;
constexpr int NPHASE = 11;

constexpr size_t MiB = 1u << 20;
constexpr size_t WS_CTL = 0, CTL_ZERO_BYTES = 1 * MiB;
constexpr size_t WS_SS = 1 * MiB;
constexpr size_t WS_W1T = 2 * MiB, WS_WOT = 7 * MiB, WS_WQT = 9 * MiB, WS_WKT = 11 * MiB, WS_WVT = 13 * MiB, WS_WXOT = 15 * MiB, WS_WUT = 17 * MiB, WS_WDT = 28 * MiB;
constexpr size_t WS_MN = 34 * MiB, WS_KB = 50 * MiB, WS_VT = 66 * MiB;
constexpr size_t WS_X1B = 82 * MiB;
constexpr size_t WS_MIX = 210 * MiB;
constexpr size_t WS_H1 = 338 * MiB;
constexpr size_t WS_PROJ = 466 * MiB;
constexpr size_t WS_ACT = 210 * MiB;
constexpr size_t WS_HF = 562 * MiB, WS_HL = 586 * MiB;
constexpr size_t WS_END = 610 * MiB;

namespace pg8 {
constexpr int BM = 256, BK = 64, HALF = 128, HTB = HALF * BK * 2, STAGE_BYTES = 8 * HTB, NXCD = 8, WGM = 8;
__host__ __device__ __forceinline__ int lds_byte(int r, int c) { const int st = (r >> 4) * 2 + (c >> 5), rr = r & 15, cc = c & 31, ob = rr * 64 + cc * 2; return st * 1024 + (ob ^ (((ob >> 9) & 1) << 5)); }
__host__ __device__ __forceinline__ void stage_rc(int b, int& R, int& C) { const int st = b / 1024, sb = b % 1024, swz = sb ^ (((sb >> 9) & 1) << 5); R = (st >> 1) * 16 + swz / 64; C = (st & 1) * 32 + (swz % 64) / 2; }
__host__ __device__ __forceinline__ int perm32(int rho) { const int n = rho >> 4, i = rho & 15; return 8 * (i >> 2) + 4 * n + (i & 3); }
struct Unit { int pm, pn; };
struct Gemm { const bf16* A; const bf16* Bt; int M, N, K; };
struct StaticOrder {
    int nM, nN, nwg, G, c;
    __host__ __device__ void init(int M, int N, int G_, int c_) { nM = M / BM; nN = N / BM; nwg = nM * nN; G = G_; c = c_; }
    __host__ __device__ bool next(int i, Unit& u) const {
        const long L = (long)i * G + c; if (L >= nwg) return false;
        int wgid = (int)L; { const int q = nwg / NXCD, r = nwg % NXCD, xcd = wgid % NXCD, off = wgid / NXCD; wgid = (xcd < r ? xcd * (q + 1) : r * (q + 1) + (xcd - r) * q) + off; }
        const int nig = WGM * nN, gid = wgid / nig, fm = gid * WGM, gsz = (nM - fm) < WGM ? (nM - fm) : WGM;
        u.pm = fm + ((wgid % nig) % gsz); u.pn = (wgid % nig) / gsz; return true;
    }
    __device__ __forceinline__ void a_ready(const Unit&) const {}
    __device__ __forceinline__ void done(const Unit&) const {}
};

DI unsigned cvtpk(float lo, float hi) { f32x2_t v = {lo, hi}; bf16x2_t b = __builtin_convertvector(v, bf16x2_t); return __builtin_bit_cast(unsigned, b); }
DI float bflo(unsigned w) { return __uint_as_float(w << 16); }
DI float bfhi(unsigned w) { return __uint_as_float(w & 0xffff0000u); }


struct EpiG1 {
    static constexpr bool PERM = true, AFTER_DRAIN = false;
    bf16* O; const float* gkb;
    DI void operator()(const f32x4 (&acc)[2][2][4][2], const Unit& u, int wr, int wc, int fr, int fq) const {
        const int row0 = u.pm * BM + wr * 64 + fr, col0 = u.pn * BM + wc * 32 + 8 * fq;
        const int mode = (u.pn == 6) ? 1 : (u.pn >= 7 ? 2 : 0);
        f32x4 bv[2][2];
#pragma unroll
        for (int bj = 0; bj < 2; ++bj)
#pragma unroll
            for (int n = 0; n < 2; ++n) bv[bj][n] = (mode == 1) ? *(const f32x4*)(gkb + (col0 - C_LG) + bj * HALF + 4 * n) : (f32x4){0.f, 0.f, 0.f, 0.f};
#pragma unroll
        for (int ai = 0; ai < 2; ++ai)
#pragma unroll
            for (int m = 0; m < 4; ++m) { bf16* rowp = O + (size_t)(row0 + ai * HALF + m * 16) * N1 + col0;
#pragma unroll
                for (int bj = 0; bj < 2; ++bj) { f32x4 v0 = acc[ai][bj][m][0], v1 = acc[ai][bj][m][1];
                    if (mode == 1) {
                        v0 = v0 + bv[bj][0]; v1 = v1 + bv[bj][1];
#pragma unroll
                        for (int j = 0; j < 4; ++j) {
                            { const float z = v0[j]; v0[j] = (fminf(z, 0.f) - __logf(1.f + __expf(-fabsf(z)))) * 0.0625f; }
                            { const float z = v1[j]; v1[j] = (fminf(z, 0.f) - __logf(1.f + __expf(-fabsf(z)))) * 0.0625f; } }
                    } else if (mode == 2) {
#pragma unroll
                        for (int j = 0; j < 4; ++j) {
                            { const float z = v0[j]; v0[j] = z * __builtin_amdgcn_rcpf(1.f + __expf(-z)); }
                            { const float z = v1[j]; v1[j] = z * __builtin_amdgcn_rcpf(1.f + __expf(-z)); } }
                    }
                    u32x4 w; w.x = cvtpk(v0[0], v0[1]); w.y = cvtpk(v0[2], v0[3]); w.z = cvtpk(v1[0], v1[1]); w.w = cvtpk(v1[2], v1[3]);
                    *(u32x4*)(rowp + bj * HALF) = w; } }
    }
};
template <bool ROWSCALE> struct EpiBf16 {
    static constexpr bool PERM = true, AFTER_DRAIN = false;
    bf16* O; int ldc; const float* ss; float cs;
    DI void operator()(const f32x4 (&acc)[2][2][4][2], const Unit& u, int wr, int wc, int fr, int fq) const {
        const int row0 = u.pm * BM + wr * 64 + fr, col0 = u.pn * BM + wc * 32 + 8 * fq;
#pragma unroll
        for (int ai = 0; ai < 2; ++ai)
#pragma unroll
            for (int m = 0; m < 4; ++m) { const int row = row0 + ai * HALF + m * 16; bf16* rowp = O + (size_t)row * ldc + col0;
                float sc = 1.f; if (ROWSCALE) sc = rsqrtf(ss[row] * (1.f / DM) + EPS) * cs;
#pragma unroll
                for (int bj = 0; bj < 2; ++bj) { const f32x4 v0 = acc[ai][bj][m][0] * sc, v1 = acc[ai][bj][m][1] * sc;
                    u32x4 w; w.x = cvtpk(v0[0], v0[1]); w.y = cvtpk(v0[2], v0[3]); w.z = cvtpk(v1[0], v1[1]); w.w = cvtpk(v1[2], v1[3]);
                    *(u32x4*)(rowp + bj * HALF) = w; } }
    }
};
template <bool RESF32> struct EpiRes {
    static constexpr bool PERM = true, AFTER_DRAIN = false;
    const void* res; bf16* O; float* ss;
    DI void operator()(const f32x4 (&acc)[2][2][4][2], const Unit& u, int wr, int wc, int fr, int fq) const {
        const int row0 = u.pm * BM + wr * 64 + fr, col0 = u.pn * BM + wc * 32 + 8 * fq;
#pragma unroll
        for (int ai = 0; ai < 2; ++ai) {
            f32x4 rf[4][2][2]; u32x4 rb[4][2];
#pragma unroll
            for (int m = 0; m < 4; ++m)
#pragma unroll
                for (int bj = 0; bj < 2; ++bj) { const size_t off = (size_t)(row0 + ai * HALF + m * 16) * DM + col0 + bj * HALF;
                    if (RESF32) { const float* rp = (const float*)res + off; rf[m][bj][0] = *(const f32x4*)rp; rf[m][bj][1] = *(const f32x4*)(rp + 4); }
                    else rb[m][bj] = *(const u32x4*)((const bf16*)res + off); }
#pragma unroll
            for (int m = 0; m < 4; ++m) { const int row = row0 + ai * HALF + m * 16; const size_t off = (size_t)row * DM + col0; float s = 0.f;
#pragma unroll
                for (int bj = 0; bj < 2; ++bj) { f32x4 r0, r1;
                    if (RESF32) { r0 = rf[m][bj][0]; r1 = rf[m][bj][1]; }
                    else { const u32x4 rw = rb[m][bj]; r0 = (f32x4){bflo(rw.x), bfhi(rw.x), bflo(rw.y), bfhi(rw.y)}; r1 = (f32x4){bflo(rw.z), bfhi(rw.z), bflo(rw.w), bfhi(rw.w)}; }
                    const f32x4 v0 = acc[ai][bj][m][0] + r0, v1 = acc[ai][bj][m][1] + r1;
                    s += (v0[0] * v0[0] + v0[1] * v0[1]) + (v0[2] * v0[2] + v0[3] * v0[3]) + (v1[0] * v1[0] + v1[1] * v1[1]) + (v1[2] * v1[2] + v1[3] * v1[3]);
                    u32x4 w; w.x = cvtpk(v0[0], v0[1]); w.y = cvtpk(v0[2], v0[3]); w.z = cvtpk(v1[0], v1[1]); w.w = cvtpk(v1[2], v1[3]);
                    *(u32x4*)(O + off + bj * HALF) = w; }
                s += __shfl_xor(s, 16); s += __shfl_xor(s, 32);
                if (fq == 0) atomicAdd(ss + row, s); }
        }
    }
};
struct EpiOut {
    static constexpr bool PERM = true, AFTER_DRAIN = false;
    const bf16* res; float* O; float* ss;
    DI void operator()(const f32x4 (&acc)[2][2][4][2], const Unit& u, int wr, int wc, int fr, int fq) const {
        const int row0 = u.pm * BM + wr * 64 + fr, col0 = u.pn * BM + wc * 32 + 8 * fq;
        u32x4 rb[2][4][2];
#pragma unroll
        for (int ai = 0; ai < 2; ++ai)
#pragma unroll
            for (int m = 0; m < 4; ++m)
#pragma unroll
                for (int bj = 0; bj < 2; ++bj) rb[ai][m][bj] = *(const u32x4*)(res + (size_t)(row0 + ai * HALF + m * 16) * DM + col0 + bj * HALF);
#pragma unroll
        for (int ai = 0; ai < 2; ++ai)
#pragma unroll
            for (int m = 0; m < 4; ++m) { const int row = row0 + ai * HALF + m * 16; const size_t off = (size_t)row * DM + col0; float s = 0.f;
#pragma unroll
                for (int bj = 0; bj < 2; ++bj) {
                    const u32x4 rw = rb[ai][m][bj];
                    const f32x4 r0 = (f32x4){bflo(rw.x), bfhi(rw.x), bflo(rw.y), bfhi(rw.y)}, r1 = (f32x4){bflo(rw.z), bfhi(rw.z), bflo(rw.w), bfhi(rw.w)};
                    const f32x4 v0 = acc[ai][bj][m][0] + r0, v1 = acc[ai][bj][m][1] + r1;
                    s += (v0[0] * v0[0] + v0[1] * v0[1]) + (v0[2] * v0[2] + v0[3] * v0[3]) + (v1[0] * v1[0] + v1[1] * v1[1]) + (v1[2] * v1[2] + v1[3] * v1[3]);
                    *(f32x4*)(O + off + bj * HALF) = v0; *(f32x4*)(O + off + bj * HALF + 4) = v1; }
                s += __shfl_xor(s, 16); s += __shfl_xor(s, 32);
                if (fq == 0) atomicAdd(ss + row, s); }
    }
};
struct EpiConv {
    static constexpr bool PERM = true, AFTER_DRAIN = false;
    bf16* ACT; bf16* HF; bf16* HL; const float* ss; const float* cw; const float* cb;
    DI void operator()(const f32x4 (&acc)[2][2][4][2], const Unit& u, int wr, int wc, int fr, int fq) const {
        const int lane = threadIdx.x & 63, col_in = wc * 32 + 8 * fq, ca = u.pn * 128 + col_in;
        const int src1 = (lane & ~15) | ((fr + 15) & 15), src2 = (lane & ~15) | ((fr + 14) & 15);
#pragma unroll
        for (int ai = 0; ai < 2; ++ai) {
            const int blk = 4 * u.pm + 2 * ai + wr, row0 = u.pm * BM + ai * HALF + wr * 64 + fr;
            float sc[4];
#pragma unroll
            for (int m = 0; m < 4; ++m) sc[m] = rsqrtf(ss[row0 + 16 * m] * (1.f / DM) + EPS);
#pragma unroll
            for (int n = 0; n < 2; ++n) {
                const int c4 = ca + 4 * n;
                asm volatile("" ::: "memory");
                const f32x4 wg0 = *(const f32x4*)(cw + c4), wg1 = *(const f32x4*)(cw + NUP + c4), wg2 = *(const f32x4*)(cw + 2 * NUP + c4), bg = *(const f32x4*)(cb + c4);
                const f32x4 wv0 = *(const f32x4*)(cw + FF + c4), wv1 = *(const f32x4*)(cw + NUP + FF + c4), wv2 = *(const f32x4*)(cw + 2 * NUP + FF + c4), bv = *(const f32x4*)(cb + FF + c4);
                f32x4 gp = (f32x4){0.f, 0.f, 0.f, 0.f}, vp = gp;
#pragma unroll
                for (int m = 0; m < 4; ++m) {
                    const f32x4 g = acc[ai][0][m][n] * sc[m], v = acc[ai][1][m][n] * sc[m];
                    f32x4 g1, g2, v1, v2;
#pragma unroll
                    for (int j = 0; j < 4; ++j) {
                        g1[j] = __shfl((fr == 15) ? gp[j] : g[j], src1); g2[j] = __shfl((fr >= 14) ? gp[j] : g[j], src2);
                        v1[j] = __shfl((fr == 15) ? vp[j] : v[j], src1); v2[j] = __shfl((fr >= 14) ? vp[j] : v[j], src2); }
                    const f32x4 gg = bg + wg0 * g2 + wg1 * g1 + wg2 * g, vv = bv + wv0 * v2 + wv1 * v1 + wv2 * v;
                    float o[4];
#pragma unroll
                    for (int j = 0; j < 4; ++j) o[j] = gg[j] * __builtin_amdgcn_rcpf(1.f + __expf(-gg[j])) * vv[j];
                    if (!(m == 0 && fr < 2)) { u32x2 w; w.x = cvtpk(o[0], o[1]); w.y = cvtpk(o[2], o[3]); *(u32x2*)(ACT + (size_t)(row0 + 16 * m) * FF + c4) = w; }
                    if ((m == 0 && fr < 2) || (m == 3 && fr >= 14)) {
                        bf16* hp = (m == 0 ? HF : HL) + ((size_t)blk * 2 + (fr & 1)) * NUP + u.pn * 256 + col_in + 4 * n;
                        u32x2 wgv; wgv.x = cvtpk(g[0], g[1]); wgv.y = cvtpk(g[2], g[3]); *(u32x2*)hp = wgv;
                        u32x2 wvv; wvv.x = cvtpk(v[0], v[1]); wvv.y = cvtpk(v[2], v[3]); *(u32x2*)(hp + 128) = wvv; }
                    gp = g; vp = v;
                }
            }
        }
    }
};

template <class Epi, class Sched, bool ALIGN_EPI = false, bool SP2 = false>
__device__ __forceinline__ void gemm_phase(LAS unsigned char* lds, const Gemm g, const Sched& S, const Epi& E) {
    const int tid = threadIdx.x, wid = __builtin_amdgcn_readfirstlane(tid >> 6), lane = tid & 63, wr = wid >> 2, wc = wid & 3, fr = lane & 15, fq = lane >> 4;
    const int K = g.K, nt = K / BK;
    unsigned voffA[2], voffB[2];
#pragma unroll
    for (int i = 0; i < 2; ++i) { int R, C; stage_rc(tid * 16 + i * 8192, R, C); const int Rb = Epi::PERM ? ((R & ~31) + perm32(R & 31)) : R;
        voffA[i] = (unsigned)(R * K + C) * 2u; voffB[i] = (unsigned)(Rb * K + C) * 2u; }
    const size_t kstep = (size_t)(BK * 2);
    const size_t hstep = (size_t)HALF * K * 2;
    const size_t tstep = 2 * hstep;
    const unsigned ldsw = (unsigned)wid * 1024u;
    const int aoff = lds_byte(wr * 64 + fr, fq * 8), boff = lds_byte(wc * 32 + fr, fq * 8);
#define PG8_SA(b, h) (((b) * 2 + (h)) * HTB)
#define PG8_SB(b, h) ((4 + (b) * 2 + (h)) * HTB)
#define PG8_STAGE(bufoff, gbase, voff) do { _Pragma("unroll") for (int _i = 0; _i < 2; ++_i) \
        __builtin_amdgcn_global_load_lds((const unsigned*)((const char*)(gbase) + (voff)[_i]), (LAS unsigned*)(lds + (bufoff) + ldsw + _i * 8192), 16, 0, 0); } while (0)
#define PG8_LDA(dst, b, h) do { _Pragma("unroll") for (int m = 0; m < 4; ++m) _Pragma("unroll") for (int k = 0; k < 2; ++k) dst[m][k] = *(const LAS bf16x8*)(lds + PG8_SA(b, h) + aoff + m * 2048 + k * 1024); } while (0)
#define PG8_LDB(dst, b, h) do { _Pragma("unroll") for (int n = 0; n < 2; ++n) _Pragma("unroll") for (int k = 0; k < 2; ++k) dst[n][k] = *(const LAS bf16x8*)(lds + PG8_SB(b, h) + boff + n * 2048 + k * 1024); } while (0)
#define PG8_MMA(ai, bj, At, Bt) do { __builtin_amdgcn_s_setprio(1); _Pragma("unroll") for (int m = 0; m < 4; ++m) _Pragma("unroll") for (int n = 0; n < 2; ++n) _Pragma("unroll") for (int k = 0; k < 2; ++k) \
        acc[ai][bj][m][n] = __builtin_amdgcn_mfma_f32_16x16x32_bf16(Bt[n][k], At[m][k], acc[ai][bj][m][n], 0, 0, 0); __builtin_amdgcn_s_setprio(0); } while (0)
#define PG8_WAIT_V(n) asm volatile("s_waitcnt vmcnt(" #n ")" ::: "memory")
#define PG8_WAIT_L(n) asm volatile("s_waitcnt lgkmcnt(" #n ")" ::: "memory")
#define PG8_BAR __builtin_amdgcn_s_barrier()
#define PG8_SCHED __builtin_amdgcn_sched_barrier(0)
    Unit cur, nxt; int ui = 0;
    if (!S.next(0, cur)) return;
    f32x4 acc[2][2][4][2];
#pragma unroll
    for (int a = 0; a < 2; ++a)
#pragma unroll
        for (int b = 0; b < 2; ++b)
#pragma unroll
            for (int m = 0; m < 4; ++m)
#pragma unroll
                for (int n = 0; n < 2; ++n) acc[a][b][m][n] = (f32x4){0.f, 0.f, 0.f, 0.f};
    bf16x8 At[4][2], B0[2][2], B1[2][2];
    const char* cA = (const char*)g.A + (size_t)cur.pm * tstep; const char* cB = (const char*)g.Bt + (size_t)cur.pn * tstep;
    S.a_ready(cur);
    if constexpr (SP2) {
        PG8_STAGE(PG8_SB(0, 0), cB, voffB); PG8_STAGE(PG8_SB(0, 1), cB + hstep, voffB); PG8_STAGE(PG8_SA(0, 0), cA, voffA); PG8_STAGE(PG8_SA(0, 1), cA + hstep, voffA);
        if (wr == 1) PG8_BAR;
        PG8_WAIT_V(2); PG8_BAR;
        PG8_STAGE(PG8_SB(1, 0), cB + kstep, voffB); PG8_STAGE(PG8_SA(1, 0), cA + kstep, voffA); PG8_STAGE(PG8_SB(1, 1), cB + hstep + kstep, voffB);
        PG8_WAIT_V(6); PG8_BAR;
    } else {
        PG8_STAGE(PG8_SB(0, 0), cB, voffB); PG8_STAGE(PG8_SA(0, 0), cA, voffA); PG8_STAGE(PG8_SB(0, 1), cB + hstep, voffB); PG8_STAGE(PG8_SA(0, 1), cA + hstep, voffA);
        if (wr == 1) PG8_BAR;
        PG8_WAIT_V(4); PG8_BAR;
        PG8_STAGE(PG8_SB(1, 0), cB + kstep, voffB); PG8_STAGE(PG8_SA(1, 0), cA + kstep, voffA); PG8_STAGE(PG8_SB(1, 1), cB + hstep + kstep, voffB);
        PG8_WAIT_V(6); PG8_BAR;
    }
    for (;;) {
        const bool has_next = S.next(ui + 1, nxt);
        const char* nA = has_next ? (const char*)g.A + (size_t)nxt.pm * tstep : cA; const char* nB = has_next ? (const char*)g.Bt + (size_t)nxt.pn * tstep : cB;
        for (int t = 0; t < nt; t += 2) {
            const bool last = (t == nt - 2);
            const char* a1 = cA + (size_t)(t + 1) * kstep;
            const char* a2 = last ? nA : cA + (size_t)(t + 2) * kstep; const char* b2 = last ? nB : cB + (size_t)(t + 2) * kstep;
            const char* a3 = a2 + kstep; const char* b3 = b2 + kstep;
            if (last && has_next) S.a_ready(nxt);
            if constexpr (SP2) {
            PG8_LDB(B0, 0, 0); PG8_LDB(B1, 0, 1); PG8_SCHED; PG8_LDA(At, 0, 0); PG8_STAGE(PG8_SA(1, 1), a1 + hstep, voffA);
            PG8_WAIT_V(8); PG8_WAIT_L(0); PG8_BAR; PG8_MMA(0, 0, At, B0); PG8_MMA(0, 1, At, B1); PG8_BAR; PG8_SCHED;
            PG8_LDA(At, 0, 1); PG8_STAGE(PG8_SB(0, 0), b2, voffB); PG8_STAGE(PG8_SB(0, 1), b2 + hstep, voffB); PG8_STAGE(PG8_SA(0, 0), a2, voffA);
            PG8_WAIT_V(8); PG8_WAIT_L(0); PG8_BAR; PG8_MMA(1, 0, At, B0); PG8_MMA(1, 1, At, B1); PG8_BAR; PG8_SCHED;
            PG8_LDB(B0, 1, 0); PG8_LDB(B1, 1, 1); PG8_SCHED; PG8_LDA(At, 1, 0); PG8_STAGE(PG8_SA(0, 1), a2 + hstep, voffA);
            PG8_WAIT_V(8); PG8_WAIT_L(0); PG8_BAR; PG8_MMA(0, 0, At, B0); PG8_MMA(0, 1, At, B1); PG8_BAR; PG8_SCHED;
            PG8_LDA(At, 1, 1); PG8_STAGE(PG8_SB(1, 0), b3, voffB); PG8_STAGE(PG8_SB(1, 1), b3 + hstep, voffB); PG8_STAGE(PG8_SA(1, 0), a3, voffA);
            PG8_WAIT_V(8); PG8_WAIT_L(0); PG8_BAR; PG8_MMA(1, 0, At, B0); PG8_MMA(1, 1, At, B1); PG8_BAR; PG8_SCHED;
            } else {
            PG8_LDB(B0, 0, 0); PG8_SCHED; PG8_LDA(At, 0, 0); PG8_STAGE(PG8_SA(1, 1), a1 + hstep, voffA);
            PG8_WAIT_L(8); PG8_BAR; PG8_WAIT_L(0); PG8_MMA(0, 0, At, B0); PG8_BAR; PG8_SCHED;
            PG8_LDB(B1, 0, 1); PG8_STAGE(PG8_SB(0, 0), b2, voffB);
            PG8_BAR; PG8_WAIT_L(0); PG8_MMA(0, 1, At, B1); PG8_BAR;
            PG8_LDA(At, 0, 1); PG8_STAGE(PG8_SA(0, 0), a2, voffA);
            PG8_BAR; PG8_WAIT_L(0); PG8_MMA(1, 0, At, B0); PG8_BAR; PG8_SCHED;
            PG8_STAGE(PG8_SB(0, 1), b2 + hstep, voffB);
            PG8_WAIT_V(6); PG8_BAR; PG8_MMA(1, 1, At, B1); PG8_BAR;
            PG8_LDB(B0, 1, 0); PG8_SCHED; PG8_LDA(At, 1, 0); PG8_STAGE(PG8_SA(0, 1), a2 + hstep, voffA);
            PG8_WAIT_L(8); PG8_BAR; PG8_WAIT_L(0); PG8_MMA(0, 0, At, B0); PG8_BAR; PG8_SCHED;
            PG8_LDB(B1, 1, 1); PG8_STAGE(PG8_SB(1, 0), b3, voffB);
            PG8_BAR; PG8_WAIT_L(0); PG8_MMA(0, 1, At, B1); PG8_BAR;
            PG8_LDA(At, 1, 1); PG8_STAGE(PG8_SA(1, 0), a3, voffA);
            PG8_BAR; PG8_WAIT_L(0); PG8_MMA(1, 0, At, B0); PG8_BAR; PG8_SCHED;
            PG8_STAGE(PG8_SB(1, 1), b3 + hstep, voffB);
            PG8_WAIT_V(6); PG8_BAR; PG8_MMA(1, 1, At, B1); PG8_BAR;
            }
        }
        if constexpr (ALIGN_EPI) { if (wr == 0) PG8_BAR; }
        if constexpr (!Epi::AFTER_DRAIN) { E(acc, cur, wr, wc, fr, fq); S.done(cur); }
        if (!has_next) break;
#pragma unroll
        for (int a = 0; a < 2; ++a)
#pragma unroll
            for (int b = 0; b < 2; ++b)
#pragma unroll
                for (int m = 0; m < 4; ++m)
#pragma unroll
                    for (int n = 0; n < 2; ++n) acc[a][b][m][n] = (f32x4){0.f, 0.f, 0.f, 0.f};
        cur = nxt; cA = nA; cB = nB; ++ui;
        if constexpr (ALIGN_EPI) { if (wr == 1) PG8_BAR; }
    }
    PG8_WAIT_V(0);
    if constexpr (!ALIGN_EPI) { if (wr == 0) PG8_BAR; }
    PG8_BAR;
#undef PG8_SA
#undef PG8_SB
#undef PG8_STAGE
#undef PG8_LDA
#undef PG8_LDB
#undef PG8_MMA
#undef PG8_WAIT_V
#undef PG8_WAIT_L
#undef PG8_BAR
#undef PG8_SCHED
}
}
using pg8::cvtpk; using pg8::bflo; using pg8::bfhi;

#ifndef PG8_SP2
#define PG8_SP2 true
#endif
#ifndef PG8_ALIGN
#define PG8_ALIGN true
#endif

constexpr int RING_OFF = 0, RING_BYTES = 131072;
constexpr int LDS_BYTES = 147456;
constexpr int LDSCTL_OFF = LDS_BYTES - 1024, MISC_OFF = LDSCTL_OFF + 320;
constexpr int NWAVES = 8;

typedef GAS unsigned gu32;
#define RLX_AGENT __ATOMIC_RELAXED, __HIP_MEMORY_SCOPE_AGENT
#define LDS_WAIT() asm volatile("s_waitcnt lgkmcnt(0)" ::: "memory")
#define VM_WAIT() asm volatile("s_waitcnt vmcnt(0)" ::: "memory")
DI unsigned f2bf(float f) { unsigned u = __builtin_bit_cast(unsigned, f); return (u + 0x7fffu + ((u >> 16) & 1u)) >> 16; }
DI unsigned pk2(float lo, float hi) { return f2bf(lo) | (f2bf(hi) << 16); }
DI float bf2f(bf16 v) { return __uint_as_float(((unsigned)v) << 16); }
DI float fexp(float x) { return __builtin_amdgcn_exp2f(x * LOG2E); }

#define XB_TMO      128
#define XB_XCNT(j)  (256  + 64 * (j))
#define XB_XSUB(j)  (1280 + 64 * (j))
#define XB_XGEN(j)  (2304 + 64 * (j))
#define XB_TOP      3328
#define XB_TOPGEN   3392
#define XCD_BAR_WORDS 3456
#define XB_SPIN_CAP (1u << 18)
constexpr int CW_BAR = 4096;
DI unsigned xb_ld(unsigned* p)              { return __hip_atomic_load(p, __ATOMIC_RELAXED, __HIP_MEMORY_SCOPE_AGENT); }
DI unsigned xb_add(unsigned* p, unsigned v) { return __hip_atomic_fetch_add(p, v, __ATOMIC_RELAXED, __HIP_MEMORY_SCOPE_AGENT); }
DI unsigned xb_xcc_id() { return (unsigned)__builtin_amdgcn_s_getreg((3 << 11) | 20) & 0xFu; }
#define XB_SPIN(cond, bar) do { unsigned _sp = 0; while (cond) { __builtin_amdgcn_s_sleep(1); \
    if ((++_sp & 255u) == 0u) { if (xb_ld(&(bar)[XB_TMO])) break; if (_sp > XB_SPIN_CAP) { atomicAdd(&(bar)[XB_TMO], 1u); break; } } } } while (0)
struct XcdBarrier { unsigned* bar; unsigned x; volatile LAS unsigned* st; };
DI XcdBarrier xcd_barrier_post(unsigned* bar, volatile LAS unsigned* st) {
    XcdBarrier b; b.bar = bar; b.x = xb_xcc_id(); b.st = st;
    if (threadIdx.x == 0) (void)xb_add(&bar[XB_XCNT(b.x)], 1u);
    return b;
}
DI void xcd_barrier_complete(unsigned* bar, unsigned x, unsigned& nloc, unsigned& nx) {
    const unsigned G = gridDim.x * gridDim.y * gridDim.z;
    unsigned sum, cnt, mine, sp = 0u;
    for (;;) {
        sum = 0u; cnt = 0u; mine = 0u;
#pragma unroll
        for (unsigned j = 0; j < 16; ++j) { const unsigned c = xb_ld(&bar[XB_XCNT(j)]); sum += c; cnt += (c > 0u) ? 1u : 0u; mine = (j == x) ? c : mine; }
        if (sum == G) break;
        __builtin_amdgcn_s_sleep(1);
        if ((++sp & 255u) == 0u) { if (xb_ld(&bar[XB_TMO])) break; if (sp > XB_SPIN_CAP) { atomicAdd(&bar[XB_TMO], 1u); break; } }
    }
    nloc = mine > 0u ? mine : 1u; nx = cnt > 0u ? cnt : 1u;
}
DI void xcd_barrier(const XcdBarrier& b) {
    asm volatile("s_waitcnt vmcnt(0)" ::: "memory");
    __syncthreads();
    if (threadIdx.x == 0) {
        unsigned* bar = b.bar;
        __builtin_amdgcn_s_waitcnt(0);
        unsigned nloc = b.st[0], nx = b.st[1];
        if (nloc == 0u) { xcd_barrier_complete(bar, b.x, nloc, nx); b.st[0] = nloc; b.st[1] = nx; }
        const unsigned old = xb_add(&bar[XB_XSUB(b.x)], 1u);
        const unsigned gen = old / nloc;
        if (old + 1u == (gen + 1u) * nloc) {
            __builtin_amdgcn_fence(__ATOMIC_RELEASE, "agent");
            asm volatile("s_waitcnt vmcnt(0)" ::: "memory");
            const unsigned og = xb_add(&bar[XB_TOP], 1u);
            const unsigned tg = og / nx;
            if (og + 1u == (tg + 1u) * nx) xb_add(&bar[XB_TOPGEN], 1u);
            else XB_SPIN(xb_ld(&bar[XB_TOPGEN]) == tg, bar);
            __builtin_amdgcn_fence(__ATOMIC_ACQUIRE, "agent");
            xb_add(&bar[XB_XGEN(b.x)], 1u);
            asm volatile("s_waitcnt vmcnt(0)" ::: "memory");
        } else {
            XB_SPIN(xb_ld(&bar[XB_XGEN(b.x)]) == gen, bar);
            __builtin_amdgcn_fence(__ATOMIC_ACQUIRE, "agent");
            asm volatile("s_waitcnt vmcnt(0)" ::: "memory");
        }
    }
    __syncthreads();
}

struct Args { const float* in[21]; float* out; unsigned char* ws; int ph_lo, ph_hi; };
struct Frame {
    LAS unsigned char* lds;
    int tid, lane, wave, vcu, G;
    const float* in[21]; float* out; unsigned char* ws;
};
DI float wave_sum(float v) {
#pragma unroll
    for (int o = 1; o < 64; o <<= 1) v += __shfl_xor(v, o);
    return v;
}

template <class F> DI void wt_item(F val, int K, bf16* WT, int nblk, LAS float* scr, int item, int lane) {
    const int kb = item / nblk, nb = item % nblk, k0 = 64 * kb, n0 = 32 * nb;
#pragma unroll 1
    for (int hb = 0; hb < 2; ++hb) {
        float tmp[16];
#pragma unroll
        for (int i = 0; i < 16; ++i) tmp[i] = val(k0 + 32 * hb + 2 * i + (lane >> 5), n0 + (lane & 31));
#pragma unroll
        for (int i = 0; i < 16; ++i) scr[(32 * hb + 2 * i + (lane >> 5)) * 33 + (lane & 31)] = tmp[i];
    }
    LDS_WAIT(); asm volatile("" ::: "memory");
    const int c = lane & 7;
#pragma unroll
    for (int j = 0; j < 4; ++j) { const int n = (lane >> 3) + 8 * j; const LAS float* s = scr + (8 * c) * 33 + n;
        u32x4 o; o.x = pk2(s[0 * 33], s[1 * 33]); o.y = pk2(s[2 * 33], s[3 * 33]); o.z = pk2(s[4 * 33], s[5 * 33]); o.w = pk2(s[6 * 33], s[7 * 33]);
        *(u32x4*)(WT + (size_t)(n0 + n) * K + k0 + 8 * c) = o; }
    LDS_WAIT(); asm volatile("" ::: "memory");
}
DI void wt_item_y(const float* win, const float* pw, const float* ps, bf16* WT, LAS float* scr, int item, int lane) {
    const int kb = item / 16, nb = item % 16, k0 = 64 * kb, n0 = 32 * nb, n = n0 + (lane & 31), g = n >> 7, d = n & 127;
    float breg[128];
    { const float sc = ps[n]; const float* b = pw + (size_t)g * 16384 + d;
#pragma unroll
      for (int c = 0; c < 128; ++c) breg[c] = b[c * 128] * sc; }
#pragma unroll 1
    for (int i = 0; i < 32; ++i) { const int kk = 2 * i + (lane >> 5); const f32x4* a = (const f32x4*)(win + (size_t)(k0 + kk) * WIN_LD + g * 128);
        float s0 = 0.f, s1 = 0.f, s2 = 0.f, s3 = 0.f;
#pragma unroll
        for (int c = 0; c < 32; ++c) { const f32x4 av = a[c]; s0 += av[0] * breg[4 * c]; s1 += av[1] * breg[4 * c + 1]; s2 += av[2] * breg[4 * c + 2]; s3 += av[3] * breg[4 * c + 3]; }
        scr[kk * 33 + (lane & 31)] = (s0 + s1) + (s2 + s3); }
    LDS_WAIT(); asm volatile("" ::: "memory");
    const int c = lane & 7;
#pragma unroll
    for (int j = 0; j < 4; ++j) { const int nn = (lane >> 3) + 8 * j; const LAS float* sp = scr + (8 * c) * 33 + nn;
        u32x4 o; o.x = pk2(sp[0 * 33], sp[1 * 33]); o.y = pk2(sp[2 * 33], sp[3 * 33]); o.z = pk2(sp[4 * 33], sp[5 * 33]); o.w = pk2(sp[6 * 33], sp[7 * 33]);
        *(u32x4*)(WT + (size_t)(n0 + nn) * DM + k0 + 8 * c) = o; }
    LDS_WAIT(); asm volatile("" ::: "memory");
}
template <int NR> DI void norm_rows_to_bf16(int lane, const float* x0, size_t rs, const f32x4 (&w)[4], bf16* o0) {
    f32x4 v[NR][4]; float s[NR];
#pragma unroll
    for (int q = 0; q < NR; ++q) { const f32x4* xr = (const f32x4*)(x0 + q * rs * DM) + lane;
#pragma unroll
        for (int j = 0; j < 4; ++j) v[q][j] = xr[64 * j]; }
#pragma unroll
    for (int q = 0; q < NR; ++q) { float t = 0.f;
#pragma unroll
        for (int j = 0; j < 4; ++j) t += (v[q][j].x * v[q][j].x + v[q][j].y * v[q][j].y) + (v[q][j].z * v[q][j].z + v[q][j].w * v[q][j].w);
        s[q] = t; }
#pragma unroll
    for (int o = 1; o < 64; o <<= 1) {
#pragma unroll
        for (int q = 0; q < NR; ++q) s[q] += __shfl_xor(s[q], o); }
#pragma unroll
    for (int q = 0; q < NR; ++q) { const float rstd = rsqrtf(s[q] * (1.f / DM) + EPS); u32x2* o8 = (u32x2*)(o0 + q * rs * DM) + lane;
#pragma unroll
        for (int j = 0; j < 4; ++j) { u32x2 o; o.x = cvtpk(v[q][j].x * rstd * w[j].x, v[q][j].y * rstd * w[j].y); o.y = cvtpk(v[q][j].z * rstd * w[j].z, v[q][j].w * rstd * w[j].w); o8[64 * j] = o; } }
}
DI void p0_prologue(Frame& F) {
    LAS float* scr = (LAS float*)(F.lds + RING_OFF + F.wave * 16384);
    const int gw = F.vcu * NWAVES + F.wave, NGW = F.G * NWAVES, lane = F.lane;
    const float* win = F.in[3]; const float* pw = F.in[4]; const float* ps = F.in[5]; const float* gw2 = F.in[6];
    const float* wout = F.in[9]; const float* nxw = F.in[10]; const float* wq = F.in[12]; const float* wkv = F.in[13]; const float* wxo = F.in[14];
    const float* nfw = F.in[15]; const float* wup = F.in[16]; const float* wdn = F.in[19];
    bf16* W1T = (bf16*)(F.ws + WS_W1T); bf16* WOT = (bf16*)(F.ws + WS_WOT); bf16* WQT = (bf16*)(F.ws + WS_WQT); bf16* WKT = (bf16*)(F.ws + WS_WKT);
    bf16* WVT = (bf16*)(F.ws + WS_WVT); bf16* WXOT = (bf16*)(F.ws + WS_WXOT); bf16* WUT = (bf16*)(F.ws + WS_WUT); bf16* WDT = (bf16*)(F.ws + WS_WDT);
    constexpr int I_Y = 16 * 16, I_QKV = 16 * 32, I_G = 16 * 8, I_R = 16 * 16, I_SQ = 16 * 32, I_UP = 16 * 176, I_DN = 44 * 32;
    constexpr int NITEMS = I_Y + I_QKV + I_G + I_R + 5 * I_SQ + I_UP + I_DN;
    for (int it = gw; it < NITEMS; it += NGW) {
        int r = it;
        if (r < I_Y) { wt_item_y(win, pw, ps, W1T, scr, r, lane); continue; } r -= I_Y;
        if (r < I_QKV) {
            wt_item([&](int k, int n) { const float v = win[(size_t)k * WIN_LD + 512 + n]; return n < 256 ? v * 0.125f : v; }, DM, W1T + (size_t)C_Q * DM, 32, scr, r, lane); continue; } r -= I_QKV;
        if (r < I_G) {
            wt_item([&](int k, int n) { const float* a = win + (size_t)k * WIN_LD + 1536; float s = 0.f;
#pragma unroll
                for (int c = 0; c < 16; ++c) s += a[c] * gw2[c * 256 + n];
                return s; }, DM, W1T + (size_t)C_LG * DM, 8, scr, r, lane); continue; } r -= I_G;
        if (r < I_R) { wt_item([&](int k, int n) { return win[(size_t)k * WIN_LD + 1552 + n]; }, DM, W1T + (size_t)C_SR * DM, 16, scr, r, lane); continue; } r -= I_R;
        if (r < I_SQ) { wt_item([&](int k, int n) { return wout[(size_t)k * DM + n]; }, DM, WOT, 32, scr, r, lane); continue; } r -= I_SQ;
        if (r < I_SQ) { wt_item([&](int k, int n) { return wq[(size_t)k * DM + n] * nxw[k]; }, DM, WQT, 32, scr, r, lane); continue; } r -= I_SQ;
        if (r < I_SQ) { wt_item([&](int k, int n) { return wkv[(size_t)k * 2048 + n]; }, DM, WKT, 32, scr, r, lane); continue; } r -= I_SQ;
        if (r < I_SQ) { wt_item([&](int k, int n) { return wkv[(size_t)k * 2048 + 1024 + n]; }, DM, WVT, 32, scr, r, lane); continue; } r -= I_SQ;
        if (r < I_SQ) { wt_item([&](int k, int n) { return wxo[(size_t)k * DM + n]; }, DM, WXOT, 32, scr, r, lane); continue; } r -= I_SQ;
        if (r < I_UP) {
            wt_item([&](int k, int n) { const int pn = n >> 8, bj = (n >> 7) & 1, j = n & 127; return wup[(size_t)k * NUP + bj * FF + pn * 128 + j] * nfw[k]; }, DM, WUT, 176, scr, r, lane); continue; } r -= I_UP;
        wt_item([&](int k, int n) { return wdn[(size_t)k * DM + n]; }, FF, WDT, 32, scr, r, lane);
    }
    { float* ss = (float*)(F.ws + WS_SS); for (int i = (F.vcu * 512 + F.tid); i < 3 * T; i += F.G * 512) ss[i] = 0.f; }
    { const float* w = F.in[2]; f32x4 wv[4];
#pragma unroll
      for (int j = 0; j < 4; ++j) wv[j] = ((const f32x4*)w)[lane + 64 * j];
      bf16* H1 = (bf16*)(F.ws + WS_H1);
      for (int m = gw; m < T; m += 4 * NGW) norm_rows_to_bf16<4>(lane, F.in[0] + (size_t)m * DM, (size_t)NGW, wv, H1 + (size_t)m * DM); }
    { const float* w = F.in[11]; f32x4 wv[4];
#pragma unroll
      for (int j = 0; j < 4; ++j) wv[j] = ((const f32x4*)w)[lane + 64 * j];
      bf16* MN = (bf16*)(F.ws + WS_MN);
      for (int m = gw; m < TM; m += 4 * NGW) norm_rows_to_bf16<4>(lane, F.in[1] + (size_t)m * DM, (size_t)NGW, wv, MN + (size_t)m * DM); }
}

DI int crow(int reg, int h) { return (reg & 3) + 8 * (reg >> 2) + 4 * h; }
#define MFMA32(a, b, c) __builtin_amdgcn_mfma_f32_32x32x16_bf16((a), (b), (c), 0, 0, 0)
constexpr int GP = 144;
DI void mma_tile(f32x16& acc, LAS const unsigned char* A, LAS const unsigned char* B, int ksteps, int lane) {
    const int r = lane & 31, h = lane >> 5;
    LAS const unsigned char* ap = A + r * GP + 16 * h; LAS const unsigned char* bp = B + r * GP + 16 * h;
    for (int ks = 0; ks < ksteps; ++ks) { const bf16x8 a = *(const LAS bf16x8*)(ap + 32 * ks), b = *(const LAS bf16x8*)(bp + 32 * ks); acc = MFMA32(a, b, acc); }
}
DI void gla_item(Frame& F, int b, int h) {
    LAS unsigned char* L = F.lds;
    constexpr int QD = 0, KD = QD + 64 * GP, KET = KD + 64 * GP, VTL = KET + 64 * GP, SC = VTL + 128 * GP, STL = SC + 64 * GP, OL = STL + 128 * GP, OLP = 528,
                  DEC = OL + 64 * OLP, TOT = DEC + 256, GEND = TOT + 2048;
    static_assert(GEND <= RING_BYTES, "GLA LDS");
    const int tid = F.tid, lane = F.lane, wave = F.wave, r = lane & 31, hh = lane >> 5;
    const bf16* proj = (const bf16*)(F.ws + WS_PROJ); bf16* mix = (bf16*)(F.ws + WS_MIX); const float* gnw = F.in[8];
    for (int i = tid; i < 128 * GP / 4; i += 512) ((LAS unsigned*)(L + STL))[i] = 0u;
    f32x16 accS;
#pragma unroll
    for (int i = 0; i < 16; ++i) accS[i] = 0.f;
    const int it_o = wave >> 2, et_o = wave & 3, et_s = wave >> 1, dt_s = wave & 1;
    __syncthreads();
    for (int n = 0; n < SEQ / 64; ++n) {
        const size_t tok0 = (size_t)b * SEQ + 64 * n;
        const bf16* base = proj + tok0 * N1;
        {
            const int d = tid & 63, tg = tid >> 6;
            float lgv[8], qv[8], kv[8];
#pragma unroll
            for (int ii = 0; ii < 8; ++ii) { const bf16* rp = base + (size_t)(8 * tg + ii) * N1 + 64 * h + d; lgv[ii] = bf2f(rp[C_LG]); qv[ii] = bf2f(rp[C_Q]); kv[ii] = bf2f(rp[C_K]); }
            {
                const int e = tid & 127, tq = tid >> 7; unsigned pkv[8];
#pragma unroll
                for (int jj = 0; jj < 8; ++jj) { const bf16* rp = base + (size_t)(16 * tq + 2 * jj) * N1 + C_V + 128 * h + e; pkv[jj] = (unsigned)rp[0] | ((unsigned)rp[N1] << 16); }
                LAS u32x4* dst = (LAS u32x4*)(L + VTL + e * GP + tq * 32);
                dst[0] = (u32x4){pkv[0], pkv[1], pkv[2], pkv[3]}; dst[1] = (u32x4){pkv[4], pkv[5], pkv[6], pkv[7]};
            }
#pragma unroll
            for (int ii = 1; ii < 8; ++ii) lgv[ii] += lgv[ii - 1];
            ((LAS float*)(L + TOT))[tg * 64 + d] = lgv[7];
            __syncthreads();
            float pre = 0.f, tot = 0.f;
#pragma unroll
            for (int g = 0; g < 8; ++g) { const float t = ((LAS float*)(L + TOT))[g * 64 + d]; tot += t; pre += (g < tg) ? t : 0.f; }
            unsigned kep[4];
#pragma unroll
            for (int ii = 0; ii < 8; ii += 2) {
                const float G0 = pre + lgv[ii], G1 = pre + lgv[ii + 1];
                const float q0 = qv[ii] * fexp(G0), q1 = qv[ii + 1] * fexp(G1);
                const float k0 = kv[ii] * fexp(-G0), k1 = kv[ii + 1] * fexp(-G1);
                const float e0 = kv[ii] * fexp(tot - G0), e1 = kv[ii + 1] * fexp(tot - G1);
                *(LAS bf16*)(L + QD + (8 * tg + ii) * GP + 2 * d) = (bf16)f2bf(q0); *(LAS bf16*)(L + QD + (8 * tg + ii + 1) * GP + 2 * d) = (bf16)f2bf(q1);
                *(LAS bf16*)(L + KD + (8 * tg + ii) * GP + 2 * d) = (bf16)f2bf(k0); *(LAS bf16*)(L + KD + (8 * tg + ii + 1) * GP + 2 * d) = (bf16)f2bf(k1);
                kep[ii >> 1] = cvtpk(e0, e1);
            }
            *(LAS u32x4*)(L + KET + d * GP + tg * 16) = (u32x4){kep[0], kep[1], kep[2], kep[3]};
            if (tg == 0) ((LAS float*)(L + DEC))[d] = fexp(tot);
        }
        __syncthreads();
        f32x16 acc_o;
#pragma unroll
        for (int i = 0; i < 16; ++i) acc_o[i] = 0.f;
        if (wave < 3) {
            const int it = (wave >= 1) ? 1 : 0, jt = (wave == 2) ? 1 : 0;
            f32x16 sc;
#pragma unroll
            for (int i = 0; i < 16; ++i) sc[i] = 0.f;
            mma_tile(sc, L + QD + it * 32 * GP, L + KD + jt * 32 * GP, 4, lane);
#pragma unroll
            for (int reg = 0; reg < 16; ++reg) { const int i = 32 * it + crow(reg, hh), j = 32 * jt + r; const float v = (j <= i) ? sc[reg] : 0.f; *(LAS bf16*)(L + SC + i * GP + 2 * j) = (bf16)f2bf(v); }
        }
        mma_tile(acc_o, L + QD + it_o * 32 * GP, L + STL + et_o * 32 * GP, 4, lane);
        { const float dec = ((LAS float*)(L + DEC))[32 * dt_s + r];
#pragma unroll
          for (int i = 0; i < 16; ++i) accS[i] *= dec;
          mma_tile(accS, L + VTL + et_s * 32 * GP, L + KET + dt_s * 32 * GP, 4, lane); }
        __syncthreads();
        mma_tile(acc_o, L + SC + it_o * 32 * GP, L + VTL + et_o * 32 * GP, 2 * (it_o + 1), lane);
#pragma unroll
        for (int reg = 0; reg < 16; ++reg) {
            *(LAS bf16*)(L + STL + (32 * et_s + crow(reg, hh)) * GP + 2 * (32 * dt_s + r)) = (bf16)f2bf(accS[reg]);
            *(LAS float*)(L + OL + (32 * it_o + crow(reg, hh)) * OLP + 4 * (32 * et_o + r)) = acc_o[reg];
        }
        __syncthreads();
        {
            const int i = tid >> 3, eg = tid & 7; float o[16]; float s = 0.f;
#pragma unroll
            for (int q = 0; q < 4; ++q) { const f32x4 v = *(LAS const f32x4*)(L + OL + i * OLP + 64 * eg + 16 * q); o[4 * q] = v[0]; o[4 * q + 1] = v[1]; o[4 * q + 2] = v[2]; o[4 * q + 3] = v[3]; s += (v[0] * v[0] + v[1] * v[1]) + (v[2] * v[2] + v[3] * v[3]); }
            s += __shfl_xor(s, 1); s += __shfl_xor(s, 2); s += __shfl_xor(s, 4);
            const float rstd = rsqrtf(s * (1.f / 128.f) + EPS);
            const bf16* srp = base + (size_t)i * N1 + C_SR + 128 * h + 16 * eg;
            const u32x4 s0 = *(const u32x4*)srp, s1 = *(const u32x4*)(srp + 8);
            const unsigned sw[8] = {s0.x, s0.y, s0.z, s0.w, s1.x, s1.y, s1.z, s1.w};
            unsigned ow[8];
#pragma unroll
            for (int q = 0; q < 8; ++q) { const float g0 = gnw[16 * eg + 2 * q], g1 = gnw[16 * eg + 2 * q + 1]; ow[q] = cvtpk(o[2 * q] * rstd * g0 * bflo(sw[q]), o[2 * q + 1] * rstd * g1 * bfhi(sw[q])); }
            bf16* op = mix + (tok0 + i) * DM + 512 + 128 * h + 16 * eg;
            *(u32x4*)op = (u32x4){ow[0], ow[1], ow[2], ow[3]}; *(u32x4*)(op + 8) = (u32x4){ow[4], ow[5], ow[6], ow[7]};
        }
    }
}
DI void pool_item(Frame& F, int item) {
    const int lane = F.lane, b = item >> 5, blk = item & 31, c0 = 8 * lane, w = 2 << (lane >> 4);
    const bf16* proj = (const bf16*)(F.ws + WS_PROJ); bf16* mix = (bf16*)(F.ws + WS_MIX);
    const size_t seq0 = (size_t)b * SEQ; const int p0 = 64 * blk;
    float s[8];
#pragma unroll
    for (int j = 0; j < 8; ++j) s[j] = 0.f;
    for (int k = 15; k >= 1; --k) { const int p = p0 - k; if (k <= w - 1 && p >= 0) { const u32x4 v = *(const u32x4*)(proj + (seq0 + p) * N1 + c0);
        s[0] += bflo(v.x); s[1] += bfhi(v.x); s[2] += bflo(v.y); s[3] += bfhi(v.y); s[4] += bflo(v.z); s[5] += bfhi(v.z); s[6] += bflo(v.w); s[7] += bfhi(v.w); } }
    for (int t = 0; t < 64; ++t) {
        const int p = p0 + t; const u32x4 v = *(const u32x4*)(proj + (seq0 + p) * N1 + c0);
        const float y[8] = {bflo(v.x), bfhi(v.x), bflo(v.y), bfhi(v.y), bflo(v.z), bfhi(v.z), bflo(v.w), bfhi(v.w)};
        const float inv = 1.f / (float)((p + 1) < w ? (p + 1) : w);
        float o[8];
#pragma unroll
        for (int j = 0; j < 8; ++j) { s[j] += y[j]; o[j] = s[j] * inv - y[j]; }
        *(u32x4*)(mix + (seq0 + p) * DM + c0) = (u32x4){cvtpk(o[0], o[1]), cvtpk(o[2], o[3]), cvtpk(o[4], o[5]), cvtpk(o[6], o[7])};
        const int pd = p - w + 1;
        if (pd >= 0) { const u32x4 u = *(const u32x4*)(proj + (seq0 + pd) * N1 + c0);
            s[0] -= bflo(u.x); s[1] -= bfhi(u.x); s[2] -= bflo(u.y); s[3] -= bfhi(u.y); s[4] -= bflo(u.z); s[5] -= bfhi(u.z); s[6] -= bflo(u.w); s[7] -= bfhi(u.w); }
    }
}

constexpr int ATT_PP = 1056, ATT_LDS = 128 * ATT_PP;
DI int swap23(int r) { return (r & ~12) | ((r & 4) << 1) | ((r & 8) >> 1); }
DI void attn_fill(LAS unsigned char* L, const bf16* src, size_t pitch_elems, int wave, int lane) {
    const unsigned loff = (unsigned)((lane & 1) * pitch_elems * 2 + (lane >> 1) * 16);
#pragma unroll
    for (int i = 0; i < 16; ++i) { const int p = wave * 16 + i;
        __builtin_amdgcn_global_load_lds((const unsigned*)((const char*)(src + (size_t)(2 * p) * pitch_elems) + loff), (LAS unsigned*)(L + p * ATT_PP), 16, 0, 0); }
}
static_assert(ATT_LDS <= LDSCTL_OFF, "attention LDS image");
DI void attn_unit(Frame& F, int unit) {
    LAS unsigned char* L = F.lds;
    int lane_ = F.lane; asm volatile("" : "+v"(lane_));
    const int lane = lane_, wave = F.wave, r = lane & 31, hh = lane >> 5;
    const int qb = unit & 7, bh = unit >> 3, b = bh >> 2, h = bh & 3;
    const bf16* Q = (const bf16*)(F.ws + WS_H1); const bf16* KB = (const bf16*)(F.ws + WS_KB); const bf16* VT = (const bf16*)(F.ws + WS_VT); bf16* O = (bf16*)(F.ws + WS_MIX);
    const size_t t0 = (size_t)b * SEQ + 256 * qb + 32 * wave;
    attn_fill(L, KB + (size_t)b * NMEM * DM + 256 * h, DM, wave, lane);
    bf16x8 qf[16];
    { const bf16* qp = Q + (t0 + r) * DM + 256 * h + 8 * hh;
#pragma unroll
      for (int ks = 0; ks < 16; ++ks) qf[ks] = *(const bf16x8*)(qp + 16 * ks); }
    VM_WAIT(); __syncthreads();
    f32x16 sacc[8];
    { const int kr = swap23(r);
      LAS const unsigned char* kbase = L + (kr >> 1) * ATT_PP + (kr & 1) * 16 + 32 * hh;
#pragma unroll
      for (int kt = 0; kt < 8; ++kt) {
#pragma unroll
        for (int i = 0; i < 16; ++i) sacc[kt][i] = 0.f;
#pragma unroll
        for (int ks = 0; ks < 16; ++ks) { const bf16x8 kf = *(LAS const bf16x8*)(kbase + kt * 16 * ATT_PP + 64 * ks); sacc[kt] = MFMA32(kf, qf[ks], sacc[kt]); }
      } }
    __syncthreads();
    attn_fill(L, VT + (size_t)(256 * h) * TM + (size_t)b * NMEM, TM, wave, lane);
    float mx = sacc[0][0];
#pragma unroll
    for (int kt = 0; kt < 8; ++kt)
#pragma unroll
        for (int i = 0; i < 16; ++i) mx = fmaxf(mx, sacc[kt][i]);
    mx = fmaxf(mx, __shfl_xor(mx, 32));
    float sum = 0.f;
    bf16x8 pf[8][2];
#pragma unroll
    for (int kt = 0; kt < 8; ++kt) {
#pragma unroll
        for (int i = 0; i < 16; ++i) { const float pv = __builtin_amdgcn_exp2f(sacc[kt][i] - mx); sacc[kt][i] = pv; sum += pv; }
#pragma unroll
        for (int s2 = 0; s2 < 2; ++s2) { u32x4 pw; pw.x = cvtpk(sacc[kt][8 * s2], sacc[kt][8 * s2 + 1]); pw.y = cvtpk(sacc[kt][8 * s2 + 2], sacc[kt][8 * s2 + 3]); pw.z = cvtpk(sacc[kt][8 * s2 + 4], sacc[kt][8 * s2 + 5]); pw.w = cvtpk(sacc[kt][8 * s2 + 6], sacc[kt][8 * s2 + 7]);
            pf[kt][s2] = __builtin_bit_cast(bf16x8, pw); }
    }
    sum += __shfl_xor(sum, 32);
    const float inv = 1.f / sum;
    VM_WAIT(); __syncthreads();
    bf16* op = O + (t0 + r) * DM + 256 * h + 4 * hh;
    LAS const unsigned char* vbase = L + (r >> 1) * ATT_PP + (r & 1) * 16 + 32 * hh;
#pragma unroll 1
    for (int dt = 0; dt < 8; ++dt) {
        f32x16 oacc;
#pragma unroll
        for (int i = 0; i < 16; ++i) oacc[i] = 0.f;
#pragma unroll
        for (int kt = 0; kt < 8; ++kt)
#pragma unroll
            for (int s2 = 0; s2 < 2; ++s2) { const bf16x8 vf = *(LAS const bf16x8*)(vbase + dt * 16 * ATT_PP + 64 * (2 * kt + s2)); oacc = MFMA32(vf, pf[kt][s2], oacc); }
#pragma unroll
        for (int g = 0; g < 4; ++g) { u32x2 w; w.x = cvtpk(oacc[4 * g] * inv, oacc[4 * g + 1] * inv); w.y = cvtpk(oacc[4 * g + 2] * inv, oacc[4 * g + 3] * inv); *(u32x2*)(op + 32 * dt + 8 * g) = w; }
    }
    __syncthreads();
}

DI void conv_fixup(Frame& F) {
    const bf16* HF = (const bf16*)(F.ws + WS_HF); const bf16* HL = (const bf16*)(F.ws + WS_HL); bf16* ACT = (bf16*)(F.ws + WS_ACT);
    const float* cw = F.in[17]; const float* cb = F.in[18];
    constexpr int NCG = FF / 8, NITEM = (T / 64) * 2 * NCG;
    for (int item = F.vcu * 512 + F.tid; item < NITEM; item += F.G * 512) {
        const int rr = item / NCG, cg = item - rr * NCG, blk = rr >> 1, rho = rr & 1, ca = 8 * cg, pn = ca >> 7, j = ca & 127, ucol = 256 * pn + j;
        const bool first = (blk & 31) == 0;
        const bf16* p0 = HF + ((size_t)blk * 2 + rho) * NUP + ucol;
        const bf16* p1 = rho ? HF + ((size_t)blk * 2) * NUP + ucol : HL + ((size_t)(blk - 1) * 2 + 1) * NUP + ucol;
        const bf16* p2 = rho ? HL + ((size_t)(blk - 1) * 2 + 1) * NUP + ucol : HL + ((size_t)(blk - 1) * 2) * NUP + ucol;
        const bool z1 = first && !rho, z2 = first;
        const u32x4 zero = (u32x4){0u, 0u, 0u, 0u};
        const u32x4 a0 = *(const u32x4*)p0, b0 = *(const u32x4*)(p0 + 128);
        const u32x4 a1 = z1 ? zero : *(const u32x4*)p1, b1 = z1 ? zero : *(const u32x4*)(p1 + 128);
        const u32x4 a2 = z2 ? zero : *(const u32x4*)p2, b2 = z2 ? zero : *(const u32x4*)(p2 + 128);
        const unsigned g0w[4] = {a0.x, a0.y, a0.z, a0.w}, v0w[4] = {b0.x, b0.y, b0.z, b0.w}, g1w[4] = {a1.x, a1.y, a1.z, a1.w}, v1w[4] = {b1.x, b1.y, b1.z, b1.w}, g2w[4] = {a2.x, a2.y, a2.z, a2.w}, v2w[4] = {b2.x, b2.y, b2.z, b2.w};
        unsigned ow[4];
#pragma unroll
        for (int q = 0; q < 4; ++q) {
            float o[2];
#pragma unroll
            for (int e = 0; e < 2; ++e) { const int c = ca + 2 * q + e;
                const float g0 = e ? bfhi(g0w[q]) : bflo(g0w[q]), g1 = e ? bfhi(g1w[q]) : bflo(g1w[q]), g2 = e ? bfhi(g2w[q]) : bflo(g2w[q]);
                const float v0 = e ? bfhi(v0w[q]) : bflo(v0w[q]), v1 = e ? bfhi(v1w[q]) : bflo(v1w[q]), v2 = e ? bfhi(v2w[q]) : bflo(v2w[q]);
                const float gg = cb[c] + cw[c] * g2 + cw[NUP + c] * g1 + cw[2 * NUP + c] * g0;
                const float vv = cb[FF + c] + cw[FF + c] * v2 + cw[NUP + FF + c] * v1 + cw[2 * NUP + FF + c] * v0;
                o[e] = gg * __builtin_amdgcn_rcpf(1.f + __expf(-gg)) * vv; }
            ow[q] = cvtpk(o[0], o[1]);
        }
        *(u32x4*)(ACT + ((size_t)blk * 64 + rho) * FF + ca) = (u32x4){ow[0], ow[1], ow[2], ow[3]};
    }
}

DI void final_norm(Frame& F) {
    const int gw = F.vcu * NWAVES + F.wave, NGW = F.G * NWAVES, lane = F.lane;
    const float* ss = (const float*)(F.ws + WS_SS) + 2 * T; const float* w = F.in[20];
    f32x4 wv[4];
#pragma unroll
    for (int j = 0; j < 4; ++j) wv[j] = ((const f32x4*)w)[lane + 64 * j];
    for (int m = gw; m < T; m += NGW) {
        const float rstd = rsqrtf(ss[m] * (1.f / DM) + EPS);
        f32x4* p = (f32x4*)(F.out + (size_t)m * DM) + lane;
#pragma unroll
        for (int j = 0; j < 4; ++j) { f32x4 v = p[64 * j]; v = v * rstd * wv[j]; p[64 * j] = v; }
    }
}

__global__ void __launch_bounds__(NWAVES * 64, 2) hymba_fwd(Args args) {
    extern __shared__ __attribute__((aligned(16))) unsigned char lds[];
    Frame F;
    F.lds = (LAS unsigned char*)lds;
    F.tid = threadIdx.x; F.lane = F.tid & 63; F.wave = __builtin_amdgcn_readfirstlane(F.tid >> 6);
    F.G = gridDim.x; { const int bx = blockIdx.x; F.vcu = (F.G % 8 == 0) ? (bx % 8) * (F.G / 8) + bx / 8 : bx; }
#pragma unroll
    for (int i = 0; i < 21; ++i) F.in[i] = args.in[i];
    F.out = args.out; F.ws = args.ws;
    volatile LAS unsigned* MISC = (volatile LAS unsigned*)(F.lds + MISC_OFF);
    for (int u = F.tid; u < (LDS_BYTES - LDSCTL_OFF) / 4; u += NWAVES * 64) ((LAS unsigned*)(F.lds + LDSCTL_OFF))[u] = 0u;
    __syncthreads();
    const int lo = args.ph_lo, hi = args.ph_hi;
    XcdBarrier bar; bar.bar = (unsigned*)(F.ws + WS_CTL) + CW_BAR; bar.x = 0; bar.st = nullptr;
    if (hi - lo > 1) bar = xcd_barrier_post((unsigned*)(F.ws + WS_CTL) + CW_BAR, MISC + 8);
#define IN(k) (lo <= (k) && (k) < hi)
    unsigned long long pr_acc = 0, pr_t0 = 0;
#define RT_NOW(t) asm volatile("s_memrealtime %0\n\ts_waitcnt lgkmcnt(0)" : "=s"(t) :: "memory")
#define PB(k) do { if ((PROBE_MASK >> (k)) & 1) { RT_NOW(pr_t0); } } while (0)
#define SEAM(k) do { if (IN(k) && IN((k) + 1)) xcd_barrier(bar); if ((PROBE_MASK >> (k)) & 1) { unsigned long long t1_; RT_NOW(t1_); pr_acc += t1_ - pr_t0; } } while (0)
    const int cid = (int)blockIdx.x;
    bf16* W1T = (bf16*)(F.ws + WS_W1T); bf16* WOT = (bf16*)(F.ws + WS_WOT); bf16* WQT = (bf16*)(F.ws + WS_WQT); bf16* WKT = (bf16*)(F.ws + WS_WKT);
    bf16* WVT = (bf16*)(F.ws + WS_WVT); bf16* WXOT = (bf16*)(F.ws + WS_WXOT); bf16* WUT = (bf16*)(F.ws + WS_WUT); bf16* WDT = (bf16*)(F.ws + WS_WDT);
    bf16* H1 = (bf16*)(F.ws + WS_H1); bf16* PROJ = (bf16*)(F.ws + WS_PROJ); bf16* MIX = (bf16*)(F.ws + WS_MIX); bf16* X1B = (bf16*)(F.ws + WS_X1B);
    bf16* MN = (bf16*)(F.ws + WS_MN); bf16* KB = (bf16*)(F.ws + WS_KB); bf16* VT = (bf16*)(F.ws + WS_VT); bf16* ACT = (bf16*)(F.ws + WS_ACT);
    float* SS1 = (float*)(F.ws + WS_SS); float* SS2 = SS1 + T; float* SS3 = SS2 + T;

    PB(0); if (IN(0)) { p0_prologue(F); } SEAM(0);
    PB(1); if (IN(1)) {
        { pg8::Gemm g{H1, W1T, T, N1, DM}; pg8::StaticOrder S; S.init(T, N1, F.G, cid); pg8::EpiG1 E{PROJ, F.in[7]};
          pg8::gemm_phase<pg8::EpiG1, pg8::StaticOrder, PG8_ALIGN, PG8_SP2>(F.lds + RING_OFF, g, S, E); }
        { pg8::Gemm g{MN, WKT, TM, DM, DM}; pg8::StaticOrder S; S.init(TM, DM, F.G, cid); pg8::EpiBf16<false> E{KB, DM, nullptr, 1.f};
          pg8::gemm_phase<pg8::EpiBf16<false>, pg8::StaticOrder, PG8_ALIGN, PG8_SP2>(F.lds + RING_OFF, g, S, E); }
        { pg8::Gemm g{WVT, MN, DM, TM, DM}; pg8::StaticOrder S; S.init(DM, TM, F.G, (cid + F.G / 2) % F.G); pg8::EpiBf16<false> E{VT, TM, nullptr, 1.f};
          pg8::gemm_phase<pg8::EpiBf16<false>, pg8::StaticOrder, PG8_ALIGN, PG8_SP2>(F.lds + RING_OFF, g, S, E); }
    } SEAM(1);
    PB(2); if (IN(2)) {
        if (cid < 128) gla_item(F, cid >> 2, cid & 3);
        else { for (int item = (cid - 128) * NWAVES + F.wave; item < NB * (SEQ / 64); item += (F.G - 128) * NWAVES) pool_item(F, item); }
    } SEAM(2);
    PB(3); if (IN(3)) { pg8::Gemm g{MIX, WOT, T, DM, DM}; pg8::StaticOrder S; S.init(T, DM, F.G, cid); pg8::EpiRes<true> E{F.in[0], X1B, SS1};
        pg8::gemm_phase<pg8::EpiRes<true>, pg8::StaticOrder, PG8_ALIGN, PG8_SP2>(F.lds + RING_OFF, g, S, E); } SEAM(3);
    PB(4); if (IN(4)) { pg8::Gemm g{X1B, WQT, T, DM, DM}; pg8::StaticOrder S; S.init(T, DM, F.G, cid); pg8::EpiBf16<true> E{H1, DM, SS1, 0.0625f * LOG2E};
        pg8::gemm_phase<pg8::EpiBf16<true>, pg8::StaticOrder, PG8_ALIGN, PG8_SP2>(F.lds + RING_OFF, g, S, E); } SEAM(4);
    PB(5); if (IN(5)) { for (int unit = F.vcu * 4; unit < F.vcu * 4 + 4; ++unit) attn_unit(F, unit); } SEAM(5);
    PB(6); if (IN(6)) { pg8::Gemm g{MIX, WXOT, T, DM, DM}; pg8::StaticOrder S; S.init(T, DM, F.G, cid); pg8::EpiRes<false> E{X1B, X1B, SS2};
        pg8::gemm_phase<pg8::EpiRes<false>, pg8::StaticOrder, PG8_ALIGN, PG8_SP2>(F.lds + RING_OFF, g, S, E); } SEAM(6);
    PB(7); if (IN(7)) { pg8::Gemm g{X1B, WUT, T, NUP, DM}; pg8::StaticOrder S; S.init(T, NUP, F.G, cid);
        pg8::EpiConv E{ACT, (bf16*)(F.ws + WS_HF), (bf16*)(F.ws + WS_HL), SS2, F.in[17], F.in[18]};
        pg8::gemm_phase<pg8::EpiConv, pg8::StaticOrder, PG8_ALIGN, PG8_SP2>(F.lds + RING_OFF, g, S, E); } SEAM(7);
    PB(8); if (IN(8)) { conv_fixup(F); } SEAM(8);
    PB(9); if (IN(9)) { pg8::Gemm g{ACT, WDT, T, DM, FF}; pg8::StaticOrder S; S.init(T, DM, F.G, cid); pg8::EpiOut E{X1B, F.out, SS3};
        pg8::gemm_phase<pg8::EpiOut, pg8::StaticOrder, PG8_ALIGN, PG8_SP2>(F.lds + RING_OFF, g, S, E); } SEAM(9);
    PB(10); if (IN(10)) { final_norm(F); }
    if (PROBE_MASK) { if ((PROBE_MASK >> 10) & 1) { unsigned long long t1_; RT_NOW(t1_); pr_acc += t1_ - pr_t0; }
        if (blockIdx.x == 0 && F.tid == 0) { unsigned long long ta, tb; RT_NOW(ta); for (;;) { RT_NOW(tb); if (tb - ta >= pr_acc) break; __builtin_amdgcn_s_sleep(8); } } }
#undef IN
#undef SEAM
}

extern "C" void kernel_launch(void* const* d_in, const int* in_sizes, int n_in, void* d_out, int out_size, void* d_ws, size_t ws_size, hipStream_t stream) {
    static int grid = 0;
    if (grid == 0) {
        if (n_in != 21 || in_sizes[0] != T * DM || out_size != T * DM || ws_size < WS_END) { fprintf(stderr, "kernel_launch: unexpected shapes (n_in %d, in0 %d, out %d, ws %zu)\n", n_in, n_in > 0 ? in_sizes[0] : -1, out_size, ws_size); grid = -1; return; }
        int dev = 0, cus = 0;
        if (hipGetDevice(&dev) != hipSuccess || hipDeviceGetAttribute(&cus, hipDeviceAttributeMultiprocessorCount, dev) != hipSuccess) { grid = -1; return; }
        if (hipFuncSetAttribute((const void*)hymba_fwd, hipFuncAttributeMaxDynamicSharedMemorySize, LDS_BYTES) != hipSuccess) { fprintf(stderr, "kernel_launch: hipFuncSetAttribute failed\n"); grid = -1; return; }
        (void)hipGetLastError();
        grid = 256; if (cus != 256) fprintf(stderr, "kernel_launch: device reports %d CUs; built for 256\n", cus);
    }
    if (grid < 0) return;
    hipMemsetAsync((char*)d_ws + WS_CTL, 0, CTL_ZERO_BYTES, stream);
    Args a{};
    for (int i = 0; i < 21; ++i) a.in[i] = (const float*)d_in[i];
    a.out = (float*)d_out; a.ws = (unsigned char*)d_ws;
#if MK_SINGLE
    a.ph_lo = 0; a.ph_hi = NPHASE;
    hipLaunchKernelGGL(hymba_fwd, dim3(grid), dim3(NWAVES * 64), LDS_BYTES, stream, a);
#else
    for (int p = 0; p < NPHASE; ++p) { a.ph_lo = p; a.ph_hi = p + 1; hipLaunchKernelGGL(hymba_fwd, dim3(grid), dim3(NWAVES * 64), LDS_BYTES, stream, a); }
#endif
}
```

```cpp
#include <hip/hip_runtime.h>
#include <cstdio>
#include <cstdint>

#define DI __device__ __forceinline__
#define LAS __attribute__((address_space(3)))
#define GAS __attribute__((address_space(1)))
typedef unsigned short bf16;
typedef short bf16x8 __attribute__((ext_vector_type(8)));
typedef float f32x4 __attribute__((ext_vector_type(4)));
typedef float f32x16 __attribute__((ext_vector_type(16)));
typedef unsigned u32x4 __attribute__((ext_vector_type(4)));
typedef unsigned u32x2 __attribute__((ext_vector_type(2)));
typedef float f32x2_t __attribute__((ext_vector_type(2)));
typedef __bf16 bf16x2_t __attribute__((ext_vector_type(2)));

#ifndef MK_SINGLE
#define MK_SINGLE 1
#endif
#ifndef PROBE_MASK
#define PROBE_MASK 0
#endif

constexpr int NB = 32, SEQ = 2048, DM = 1024, T = NB * SEQ;
constexpr int NMEM = 256, TM = NB * NMEM;
constexpr int N1 = 2304;
constexpr int C_Y = 0, C_Q = 512, C_K = 768, C_V = 1024, C_LG = 1536, C_SR = 1792;
constexpr int WIN_LD = 2064;
constexpr int FF = 2816, NUP = 2 * FF;
constexpr float EPS = 1e-6f;
constexpr float LOG2E = 1.4426950408889634f;
constexpr int NPHASE = 11;

constexpr size_t MiB = 1u << 20;
constexpr size_t WS_CTL = 0, CTL_ZERO_BYTES = 1 * MiB;
constexpr size_t WS_SS = 1 * MiB;
constexpr size_t WS_W1T = 2 * MiB, WS_WOT = 7 * MiB, WS_WQT = 9 * MiB, WS_WKT = 11 * MiB, WS_WVT = 13 * MiB, WS_WXOT = 15 * MiB, WS_WUT = 17 * MiB, WS_WDT = 28 * MiB;
constexpr size_t WS_MN = 34 * MiB, WS_KB = 50 * MiB, WS_VT = 66 * MiB;
constexpr size_t WS_X1B = 82 * MiB;
constexpr size_t WS_MIX = 210 * MiB;
constexpr size_t WS_H1 = 338 * MiB;
constexpr size_t WS_PROJ = 466 * MiB;
constexpr size_t WS_ACT = 210 * MiB;
constexpr size_t WS_HF = 562 * MiB, WS_HL = 586 * MiB;
constexpr size_t WS_END = 610 * MiB;

namespace pg8 {
constexpr int BM = 256, BK = 64, HALF = 128, HTB = HALF * BK * 2, STAGE_BYTES = 8 * HTB, NXCD = 8, WGM = 8;
__host__ __device__ __forceinline__ int lds_byte(int r, int c) { const int st = (r >> 4) * 2 + (c >> 5), rr = r & 15, cc = c & 31, ob = rr * 64 + cc * 2; return st * 1024 + (ob ^ (((ob >> 9) & 1) << 5)); }
__host__ __device__ __forceinline__ void stage_rc(int b, int& R, int& C) { const int st = b / 1024, sb = b % 1024, swz = sb ^ (((sb >> 9) & 1) << 5); R = (st >> 1) * 16 + swz / 64; C = (st & 1) * 32 + (swz % 64) / 2; }
__host__ __device__ __forceinline__ int perm32(int rho) { const int n = rho >> 4, i = rho & 15; return 8 * (i >> 2) + 4 * n + (i & 3); }
struct Unit { int pm, pn; };
struct Gemm { const bf16* A; const bf16* Bt; int M, N, K; };
struct StaticOrder {
    int nM, nN, nwg, G, c;
    __host__ __device__ void init(int M, int N, int G_, int c_) { nM = M / BM; nN = N / BM; nwg = nM * nN; G = G_; c = c_; }
    __host__ __device__ bool next(int i, Unit& u) const {
        const long L = (long)i * G + c; if (L >= nwg) return false;
        int wgid = (int)L; { const int q = nwg / NXCD, r = nwg % NXCD, xcd = wgid % NXCD, off = wgid / NXCD; wgid = (xcd < r ? xcd * (q + 1) : r * (q + 1) + (xcd - r) * q) + off; }
        const int nig = WGM * nN, gid = wgid / nig, fm = gid * WGM, gsz = (nM - fm) < WGM ? (nM - fm) : WGM;
        u.pm = fm + ((wgid % nig) % gsz); u.pn = (wgid % nig) / gsz; return true;
    }
    __device__ __forceinline__ void a_ready(const Unit&) const {}
    __device__ __forceinline__ void done(const Unit&) const {}
};

DI unsigned cvtpk(float lo, float hi) { f32x2_t v = {lo, hi}; bf16x2_t b = __builtin_convertvector(v, bf16x2_t); return __builtin_bit_cast(unsigned, b); }
DI float bflo(unsigned w) { return __uint_as_float(w << 16); }
DI float bfhi(unsigned w) { return __uint_as_float(w & 0xffff0000u); }


struct EpiG1 {
    static constexpr bool PERM = true, AFTER_DRAIN = false;
    bf16* O; const float* gkb;
    DI void operator()(const f32x4 (&acc)[2][2][4][2], const Unit& u, int wr, int wc, int fr, int fq) const {
        const int row0 = u.pm * BM + wr * 64 + fr, col0 = u.pn * BM + wc * 32 + 8 * fq;
        const int mode = (u.pn == 6) ? 1 : (u.pn >= 7 ? 2 : 0);
        f32x4 bv[2][2];
#pragma unroll
        for (int bj = 0; bj < 2; ++bj)
#pragma unroll
            for (int n = 0; n < 2; ++n) bv[bj][n] = (mode == 1) ? *(const f32x4*)(gkb + (col0 - C_LG) + bj * HALF + 4 * n) : (f32x4){0.f, 0.f, 0.f, 0.f};
#pragma unroll
        for (int ai = 0; ai < 2; ++ai)
#pragma unroll
            for (int m = 0; m < 4; ++m) { bf16* rowp = O + (size_t)(row0 + ai * HALF + m * 16) * N1 + col0;
#pragma unroll
                for (int bj = 0; bj < 2; ++bj) { f32x4 v0 = acc[ai][bj][m][0], v1 = acc[ai][bj][m][1];
                    if (mode == 1) {
                        v0 = v0 + bv[bj][0]; v1 = v1 + bv[bj][1];
#pragma unroll
                        for (int j = 0; j < 4; ++j) {
                            { const float z = v0[j]; v0[j] = (fminf(z, 0.f) - __logf(1.f + __expf(-fabsf(z)))) * 0.0625f; }
                            { const float z = v1[j]; v1[j] = (fminf(z, 0.f) - __logf(1.f + __expf(-fabsf(z)))) * 0.0625f; } }
                    } else if (mode == 2) {
#pragma unroll
                        for (int j = 0; j < 4; ++j) {
                            { const float z = v0[j]; v0[j] = z * __builtin_amdgcn_rcpf(1.f + __expf(-z)); }
                            { const float z = v1[j]; v1[j] = z * __builtin_amdgcn_rcpf(1.f + __expf(-z)); } }
                    }
                    u32x4 w; w.x = cvtpk(v0[0], v0[1]); w.y = cvtpk(v0[2], v0[3]); w.z = cvtpk(v1[0], v1[1]); w.w = cvtpk(v1[2], v1[3]);
                    *(u32x4*)(rowp + bj * HALF) = w; } }
    }
};
template <bool ROWSCALE> struct EpiBf16 {
    static constexpr bool PERM = true, AFTER_DRAIN = false;
    bf16* O; int ldc; const float* ss; float cs;
    DI void operator()(const f32x4 (&acc)[2][2][4][2], const Unit& u, int wr, int wc, int fr, int fq) const {
        const int row0 = u.pm * BM + wr * 64 + fr, col0 = u.pn * BM + wc * 32 + 8 * fq;
#pragma unroll
        for (int ai = 0; ai < 2; ++ai)
#pragma unroll
            for (int m = 0; m < 4; ++m) { const int row = row0 + ai * HALF + m * 16; bf16* rowp = O + (size_t)row * ldc + col0;
                float sc = 1.f; if (ROWSCALE) sc = rsqrtf(ss[row] * (1.f / DM) + EPS) * cs;
#pragma unroll
                for (int bj = 0; bj < 2; ++bj) { const f32x4 v0 = acc[ai][bj][m][0] * sc, v1 = acc[ai][bj][m][1] * sc;
                    u32x4 w; w.x = cvtpk(v0[0], v0[1]); w.y = cvtpk(v0[2], v0[3]); w.z = cvtpk(v1[0], v1[1]); w.w = cvtpk(v1[2], v1[3]);
                    *(u32x4*)(rowp + bj * HALF) = w; } }
    }
};
template <bool RESF32> struct EpiRes {
    static constexpr bool PERM = true, AFTER_DRAIN = false;
    const void* res; bf16* O; float* ss;
    DI void operator()(const f32x4 (&acc)[2][2][4][2], const Unit& u, int wr, int wc, int fr, int fq) const {
        const int row0 = u.pm * BM + wr * 64 + fr, col0 = u.pn * BM + wc * 32 + 8 * fq;
#pragma unroll
        for (int ai = 0; ai < 2; ++ai) {
            f32x4 rf[4][2][2]; u32x4 rb[4][2];
#pragma unroll
            for (int m = 0; m < 4; ++m)
#pragma unroll
                for (int bj = 0; bj < 2; ++bj) { const size_t off = (size_t)(row0 + ai * HALF + m * 16) * DM + col0 + bj * HALF;
                    if (RESF32) { const float* rp = (const float*)res + off; rf[m][bj][0] = *(const f32x4*)rp; rf[m][bj][1] = *(const f32x4*)(rp + 4); }
                    else rb[m][bj] = *(const u32x4*)((const bf16*)res + off); }
#pragma unroll
            for (int m = 0; m < 4; ++m) { const int row = row0 + ai * HALF + m * 16; const size_t off = (size_t)row * DM + col0; float s = 0.f;
#pragma unroll
                for (int bj = 0; bj < 2; ++bj) { f32x4 r0, r1;
                    if (RESF32) { r0 = rf[m][bj][0]; r1 = rf[m][bj][1]; }
                    else { const u32x4 rw = rb[m][bj]; r0 = (f32x4){bflo(rw.x), bfhi(rw.x), bflo(rw.y), bfhi(rw.y)}; r1 = (f32x4){bflo(rw.z), bfhi(rw.z), bflo(rw.w), bfhi(rw.w)}; }
                    const f32x4 v0 = acc[ai][bj][m][0] + r0, v1 = acc[ai][bj][m][1] + r1;
                    s += (v0[0] * v0[0] + v0[1] * v0[1]) + (v0[2] * v0[2] + v0[3] * v0[3]) + (v1[0] * v1[0] + v1[1] * v1[1]) + (v1[2] * v1[2] + v1[3] * v1[3]);
                    u32x4 w; w.x = cvtpk(v0[0], v0[1]); w.y = cvtpk(v0[2], v0[3]); w.z = cvtpk(v1[0], v1[1]); w.w = cvtpk(v1[2], v1[3]);
                    *(u32x4*)(O + off + bj * HALF) = w; }
                s += __shfl_xor(s, 16); s += __shfl_xor(s, 32);
                if (fq == 0) atomicAdd(ss + row, s); }
        }
    }
};
struct EpiOut {
    static constexpr bool PERM = true, AFTER_DRAIN = false;
    const bf16* res; float* O; float* ss;
    DI void operator()(const f32x4 (&acc)[2][2][4][2], const Unit& u, int wr, int wc, int fr, int fq) const {
        const int row0 = u.pm * BM + wr * 64 + fr, col0 = u.pn * BM + wc * 32 + 8 * fq;
        u32x4 rb[2][4][2];
#pragma unroll
        for (int ai = 0; ai < 2; ++ai)
#pragma unroll
            for (int m = 0; m < 4; ++m)
#pragma unroll
                for (int bj = 0; bj < 2; ++bj) rb[ai][m][bj] = *(const u32x4*)(res + (size_t)(row0 + ai * HALF + m * 16) * DM + col0 + bj * HALF);
#pragma unroll
        for (int ai = 0; ai < 2; ++ai)
#pragma unroll
            for (int m = 0; m < 4; ++m) { const int row = row0 + ai * HALF + m * 16; const size_t off = (size_t)row * DM + col0; float s = 0.f;
#pragma unroll
                for (int bj = 0; bj < 2; ++bj) {
                    const u32x4 rw = rb[ai][m][bj];
                    const f32x4 r0 = (f32x4){bflo(rw.x), bfhi(rw.x), bflo(rw.y), bfhi(rw.y)}, r1 = (f32x4){bflo(rw.z), bfhi(rw.z), bflo(rw.w), bfhi(rw.w)};
                    const f32x4 v0 = acc[ai][bj][m][0] + r0, v1 = acc[ai][bj][m][1] + r1;
                    s += (v0[0] * v0[0] + v0[1] * v0[1]) + (v0[2] * v0[2] + v0[3] * v0[3]) + (v1[0] * v1[0] + v1[1] * v1[1]) + (v1[2] * v1[2] + v1[3] * v1[3]);
                    *(f32x4*)(O + off + bj * HALF) = v0; *(f32x4*)(O + off + bj * HALF + 4) = v1; }
                s += __shfl_xor(s, 16); s += __shfl_xor(s, 32);
                if (fq == 0) atomicAdd(ss + row, s); }
    }
};
template <int CTRL> DI float ror_dpp(float x) { return __builtin_bit_cast(float, __builtin_amdgcn_update_dpp(0, __builtin_bit_cast(int, x), CTRL, 0xf, 0xf, false)); }
struct EpiConv {
    static constexpr bool PERM = true, AFTER_DRAIN = false;
    bf16* ACT; bf16* HF; bf16* HL; const float* ss; const float* cw; const float* cb;
    DI void operator()(const f32x4 (&acc)[2][2][4][2], const Unit& u, int wr, int wc, int fr, int fq) const {
        const int lane = threadIdx.x & 63, col_in = wc * 32 + 8 * fq, ca = u.pn * 128 + col_in;
#pragma unroll
        for (int ai = 0; ai < 2; ++ai) {
            const int blk = 4 * u.pm + 2 * ai + wr, row0 = u.pm * BM + ai * HALF + wr * 64 + fr;
            float sc[4];
#pragma unroll
            for (int m = 0; m < 4; ++m) sc[m] = rsqrtf(ss[row0 + 16 * m] * (1.f / DM) + EPS);
#pragma unroll
            for (int n = 0; n < 2; ++n) {
                const int c4 = ca + 4 * n;
                asm volatile("" ::: "memory");
                const f32x4 wg0 = *(const f32x4*)(cw + c4), wg1 = *(const f32x4*)(cw + NUP + c4), wg2 = *(const f32x4*)(cw + 2 * NUP + c4), bg = *(const f32x4*)(cb + c4);
                const f32x4 wv0 = *(const f32x4*)(cw + FF + c4), wv1 = *(const f32x4*)(cw + NUP + FF + c4), wv2 = *(const f32x4*)(cw + 2 * NUP + FF + c4), bv = *(const f32x4*)(cb + FF + c4);
                f32x4 gp = (f32x4){0.f, 0.f, 0.f, 0.f}, vp = gp;
#pragma unroll
                for (int m = 0; m < 4; ++m) {
                    const f32x4 g = acc[ai][0][m][n] * sc[m], v = acc[ai][1][m][n] * sc[m];
                    f32x4 g1, g2, v1, v2;
#pragma unroll
                    for (int j = 0; j < 4; ++j) {
                        g1[j] = ror_dpp<0x121>((fr == 15) ? gp[j] : g[j]); g2[j] = ror_dpp<0x122>((fr >= 14) ? gp[j] : g[j]);
                        v1[j] = ror_dpp<0x121>((fr == 15) ? vp[j] : v[j]); v2[j] = ror_dpp<0x122>((fr >= 14) ? vp[j] : v[j]); }
                    const f32x4 gg = bg + wg0 * g2 + wg1 * g1 + wg2 * g, vv = bv + wv0 * v2 + wv1 * v1 + wv2 * v;
                    float o[4];
#pragma unroll
                    for (int j = 0; j < 4; ++j) o[j] = gg[j] * __builtin_amdgcn_rcpf(1.f + __expf(-gg[j])) * vv[j];
                    if (!(m == 0 && fr < 2)) { u32x2 w; w.x = cvtpk(o[0], o[1]); w.y = cvtpk(o[2], o[3]); *(u32x2*)(ACT + (size_t)(row0 + 16 * m) * FF + c4) = w; }
                    if ((m == 0 && fr < 2) || (m == 3 && fr >= 14)) {
                        bf16* hp = (m == 0 ? HF : HL) + ((size_t)blk * 2 + (fr & 1)) * NUP + u.pn * 256 + col_in + 4 * n;
                        u32x2 wgv; wgv.x = cvtpk(g[0], g[1]); wgv.y = cvtpk(g[2], g[3]); *(u32x2*)hp = wgv;
                        u32x2 wvv; wvv.x = cvtpk(v[0], v[1]); wvv.y = cvtpk(v[2], v[3]); *(u32x2*)(hp + 128) = wvv; }
                    gp = g; vp = v;
                }
            }
        }
    }
};

template <class Epi, class Sched, bool ALIGN_EPI = false, bool SP2 = false>
__device__ __forceinline__ void gemm_phase(LAS unsigned char* lds, const Gemm g, const Sched& S, const Epi& E) {
    const int tid = threadIdx.x, wid = __builtin_amdgcn_readfirstlane(tid >> 6), lane = tid & 63, wr = wid >> 2, wc = wid & 3, fr = lane & 15, fq = lane >> 4;
    const int K = g.K, nt = K / BK;
    unsigned voffA[2], voffB[2];
#pragma unroll
    for (int i = 0; i < 2; ++i) { int R, C; stage_rc(tid * 16 + i * 8192, R, C); const int Rb = Epi::PERM ? ((R & ~31) + perm32(R & 31)) : R;
        voffA[i] = (unsigned)(R * K + C) * 2u; voffB[i] = (unsigned)(Rb * K + C) * 2u; }
    const size_t kstep = (size_t)(BK * 2);
    const size_t hstep = (size_t)HALF * K * 2;
    const size_t tstep = 2 * hstep;
    const unsigned ldsw = (unsigned)wid * 1024u;
    const int aoff = lds_byte(wr * 64 + fr, fq * 8), boff = lds_byte(wc * 32 + fr, fq * 8);
#define PG8_SA(b, h) (((b) * 2 + (h)) * HTB)
#define PG8_SB(b, h) ((4 + (b) * 2 + (h)) * HTB)
#define PG8_STAGE(bufoff, gbase, voff) do { _Pragma("unroll") for (int _i = 0; _i < 2; ++_i) \
        __builtin_amdgcn_global_load_lds((const unsigned*)((const char*)(gbase) + (voff)[_i]), (LAS unsigned*)(lds + (bufoff) + ldsw + _i * 8192), 16, 0, 0); } while (0)
#define PG8_LDA(dst, b, h) do { _Pragma("unroll") for (int m = 0; m < 4; ++m) _Pragma("unroll") for (int k = 0; k < 2; ++k) dst[m][k] = *(const LAS bf16x8*)(lds + PG8_SA(b, h) + aoff + m * 2048 + k * 1024); } while (0)
#define PG8_LDB(dst, b, h) do { _Pragma("unroll") for (int n = 0; n < 2; ++n) _Pragma("unroll") for (int k = 0; k < 2; ++k) dst[n][k] = *(const LAS bf16x8*)(lds + PG8_SB(b, h) + boff + n * 2048 + k * 1024); } while (0)
#define PG8_MMA(ai, bj, At, Bt) do { __builtin_amdgcn_s_setprio(1); _Pragma("unroll") for (int m = 0; m < 4; ++m) _Pragma("unroll") for (int n = 0; n < 2; ++n) _Pragma("unroll") for (int k = 0; k < 2; ++k) \
        acc[ai][bj][m][n] = __builtin_amdgcn_mfma_f32_16x16x32_bf16(Bt[n][k], At[m][k], acc[ai][bj][m][n], 0, 0, 0); __builtin_amdgcn_s_setprio(0); } while (0)
#define PG8_WAIT_V(n) asm volatile("s_waitcnt vmcnt(" #n ")" ::: "memory")
#define PG8_WAIT_L(n) asm volatile("s_waitcnt lgkmcnt(" #n ")" ::: "memory")
#define PG8_BAR __builtin_amdgcn_s_barrier()
#define PG8_SCHED __builtin_amdgcn_sched_barrier(0)
    Unit cur, nxt; int ui = 0;
    if (!S.next(0, cur)) return;
    f32x4 acc[2][2][4][2];
#pragma unroll
    for (int a = 0; a < 2; ++a)
#pragma unroll
        for (int b = 0; b < 2; ++b)
#pragma unroll
            for (int m = 0; m < 4; ++m)
#pragma unroll
                for (int n = 0; n < 2; ++n) acc[a][b][m][n] = (f32x4){0.f, 0.f, 0.f, 0.f};
    bf16x8 At[4][2], B0[2][2], B1[2][2];
    const char* cA = (const char*)g.A + (size_t)cur.pm * tstep; const char* cB = (const char*)g.Bt + (size_t)cur.pn * tstep;
    S.a_ready(cur);
    if constexpr (SP2) {
        PG8_STAGE(PG8_SB(0, 0), cB, voffB); PG8_STAGE(PG8_SB(0, 1), cB + hstep, voffB); PG8_STAGE(PG8_SA(0, 0), cA, voffA); PG8_STAGE(PG8_SA(0, 1), cA + hstep, voffA);
        if (wr == 1) PG8_BAR;
        PG8_WAIT_V(2); PG8_BAR;
        PG8_STAGE(PG8_SB(1, 0), cB + kstep, voffB); PG8_STAGE(PG8_SA(1, 0), cA + kstep, voffA); PG8_STAGE(PG8_SB(1, 1), cB + hstep + kstep, voffB);
        PG8_WAIT_V(6); PG8_BAR;
    } else {
        PG8_STAGE(PG8_SB(0, 0), cB, voffB); PG8_STAGE(PG8_SA(0, 0), cA, voffA); PG8_STAGE(PG8_SB(0, 1), cB + hstep, voffB); PG8_STAGE(PG8_SA(0, 1), cA + hstep, voffA);
        if (wr == 1) PG8_BAR;
        PG8_WAIT_V(4); PG8_BAR;
        PG8_STAGE(PG8_SB(1, 0), cB + kstep, voffB); PG8_STAGE(PG8_SA(1, 0), cA + kstep, voffA); PG8_STAGE(PG8_SB(1, 1), cB + hstep + kstep, voffB);
        PG8_WAIT_V(6); PG8_BAR;
    }
    for (;;) {
        const bool has_next = S.next(ui + 1, nxt);
        const char* nA = has_next ? (const char*)g.A + (size_t)nxt.pm * tstep : cA; const char* nB = has_next ? (const char*)g.Bt + (size_t)nxt.pn * tstep : cB;
        for (int t = 0; t < nt; t += 2) {
            const bool last = (t == nt - 2);
            const char* a1 = cA + (size_t)(t + 1) * kstep;
            const char* a2 = last ? nA : cA + (size_t)(t + 2) * kstep; const char* b2 = last ? nB : cB + (size_t)(t + 2) * kstep;
            const char* a3 = a2 + kstep; const char* b3 = b2 + kstep;
            if (last && has_next) S.a_ready(nxt);
            if constexpr (SP2) {
            PG8_LDB(B0, 0, 0); PG8_LDB(B1, 0, 1); PG8_SCHED; PG8_LDA(At, 0, 0); PG8_STAGE(PG8_SA(1, 1), a1 + hstep, voffA);
            PG8_WAIT_V(8); PG8_WAIT_L(0); PG8_BAR; PG8_MMA(0, 0, At, B0); PG8_MMA(0, 1, At, B1); PG8_BAR; PG8_SCHED;
            PG8_LDA(At, 0, 1); PG8_STAGE(PG8_SB(0, 0), b2, voffB); PG8_STAGE(PG8_SB(0, 1), b2 + hstep, voffB); PG8_STAGE(PG8_SA(0, 0), a2, voffA);
            PG8_WAIT_V(8); PG8_WAIT_L(0); PG8_BAR; PG8_MMA(1, 0, At, B0); PG8_MMA(1, 1, At, B1); PG8_BAR; PG8_SCHED;
            PG8_LDB(B0, 1, 0); PG8_LDB(B1, 1, 1); PG8_SCHED; PG8_LDA(At, 1, 0); PG8_STAGE(PG8_SA(0, 1), a2 + hstep, voffA);
            PG8_WAIT_V(8); PG8_WAIT_L(0); PG8_BAR; PG8_MMA(0, 0, At, B0); PG8_MMA(0, 1, At, B1); PG8_BAR; PG8_SCHED;
            PG8_LDA(At, 1, 1); PG8_STAGE(PG8_SB(1, 0), b3, voffB); PG8_STAGE(PG8_SB(1, 1), b3 + hstep, voffB); PG8_STAGE(PG8_SA(1, 0), a3, voffA);
            PG8_WAIT_V(8); PG8_WAIT_L(0); PG8_BAR; PG8_MMA(1, 0, At, B0); PG8_MMA(1, 1, At, B1); PG8_BAR; PG8_SCHED;
            } else {
            PG8_LDB(B0, 0, 0); PG8_SCHED; PG8_LDA(At, 0, 0); PG8_STAGE(PG8_SA(1, 1), a1 + hstep, voffA);
            PG8_WAIT_L(8); PG8_BAR; PG8_WAIT_L(0); PG8_MMA(0, 0, At, B0); PG8_BAR; PG8_SCHED;
            PG8_LDB(B1, 0, 1); PG8_STAGE(PG8_SB(0, 0), b2, voffB);
            PG8_BAR; PG8_WAIT_L(0); PG8_MMA(0, 1, At, B1); PG8_BAR;
            PG8_LDA(At, 0, 1); PG8_STAGE(PG8_SA(0, 0), a2, voffA);
            PG8_BAR; PG8_WAIT_L(0); PG8_MMA(1, 0, At, B0); PG8_BAR; PG8_SCHED;
            PG8_STAGE(PG8_SB(0, 1), b2 + hstep, voffB);
            PG8_WAIT_V(6); PG8_BAR; PG8_MMA(1, 1, At, B1); PG8_BAR;
            PG8_LDB(B0, 1, 0); PG8_SCHED; PG8_LDA(At, 1, 0); PG8_STAGE(PG8_SA(0, 1), a2 + hstep, voffA);
            PG8_WAIT_L(8); PG8_BAR; PG8_WAIT_L(0); PG8_MMA(0, 0, At, B0); PG8_BAR; PG8_SCHED;
            PG8_LDB(B1, 1, 1); PG8_STAGE(PG8_SB(1, 0), b3, voffB);
            PG8_BAR; PG8_WAIT_L(0); PG8_MMA(0, 1, At, B1); PG8_BAR;
            PG8_LDA(At, 1, 1); PG8_STAGE(PG8_SA(1, 0), a3, voffA);
            PG8_BAR; PG8_WAIT_L(0); PG8_MMA(1, 0, At, B0); PG8_BAR; PG8_SCHED;
            PG8_STAGE(PG8_SB(1, 1), b3 + hstep, voffB);
            PG8_WAIT_V(6); PG8_BAR; PG8_MMA(1, 1, At, B1); PG8_BAR;
            }
        }
        if constexpr (ALIGN_EPI) { if (wr == 0) PG8_BAR; }
        if constexpr (!Epi::AFTER_DRAIN) { E(acc, cur, wr, wc, fr, fq); S.done(cur); }
        if (!has_next) break;
#pragma unroll
        for (int a = 0; a < 2; ++a)
#pragma unroll
            for (int b = 0; b < 2; ++b)
#pragma unroll
                for (int m = 0; m < 4; ++m)
#pragma unroll
                    for (int n = 0; n < 2; ++n) acc[a][b][m][n] = (f32x4){0.f, 0.f, 0.f, 0.f};
        cur = nxt; cA = nA; cB = nB; ++ui;
        if constexpr (ALIGN_EPI) { if (wr == 1) PG8_BAR; }
    }
    PG8_WAIT_V(0);
    if constexpr (!ALIGN_EPI) { if (wr == 0) PG8_BAR; }
    PG8_BAR;
#undef PG8_SA
#undef PG8_SB
#undef PG8_STAGE
#undef PG8_LDA
#undef PG8_LDB
#undef PG8_MMA
#undef PG8_WAIT_V
#undef PG8_WAIT_L
#undef PG8_BAR
#undef PG8_SCHED
}
}
using pg8::cvtpk; using pg8::bflo; using pg8::bfhi;

#ifndef PG8_SP2
#define PG8_SP2 true
#endif
#ifndef PG8_ALIGN
#define PG8_ALIGN true
#endif

constexpr int RING_OFF = 0, RING_BYTES = 131072;
constexpr int LDS_BYTES = 147456;
constexpr int LDSCTL_OFF = LDS_BYTES - 1024, MISC_OFF = LDSCTL_OFF + 320;
constexpr int NWAVES = 8;

typedef GAS unsigned gu32;
#define RLX_AGENT __ATOMIC_RELAXED, __HIP_MEMORY_SCOPE_AGENT
#define LDS_WAIT() asm volatile("s_waitcnt lgkmcnt(0)" ::: "memory")
#define VM_WAIT() asm volatile("s_waitcnt vmcnt(0)" ::: "memory")
DI unsigned f2bf(float f) { unsigned u = __builtin_bit_cast(unsigned, f); return (u + 0x7fffu + ((u >> 16) & 1u)) >> 16; }
DI unsigned pk2(float lo, float hi) { return f2bf(lo) | (f2bf(hi) << 16); }
DI float bf2f(bf16 v) { return __uint_as_float(((unsigned)v) << 16); }
DI float fexp(float x) { return __builtin_amdgcn_exp2f(x * LOG2E); }

#define XB_TMO      128
#define XB_XCNT(j)  (256  + 64 * (j))
#define XB_XSUB(j)  (1280 + 64 * (j))
#define XB_XGEN(j)  (2304 + 64 * (j))
#define XB_TOP      3328
#define XB_TOPGEN   3392
#define XCD_BAR_WORDS 3456
#define XB_SPIN_CAP (1u << 18)
constexpr int CW_BAR = 4096;
DI unsigned xb_ld(unsigned* p)              { return __hip_atomic_load(p, __ATOMIC_RELAXED, __HIP_MEMORY_SCOPE_AGENT); }
DI unsigned xb_add(unsigned* p, unsigned v) { return __hip_atomic_fetch_add(p, v, __ATOMIC_RELAXED, __HIP_MEMORY_SCOPE_AGENT); }
DI unsigned xb_xcc_id() { return (unsigned)__builtin_amdgcn_s_getreg((3 << 11) | 20) & 0xFu; }
#define XB_SPIN(cond, bar) do { unsigned _sp = 0; while (cond) { __builtin_amdgcn_s_sleep(1); \
    if ((++_sp & 255u) == 0u) { if (xb_ld(&(bar)[XB_TMO])) break; if (_sp > XB_SPIN_CAP) { atomicAdd(&(bar)[XB_TMO], 1u); break; } } } } while (0)
struct XcdBarrier { unsigned* bar; unsigned x; volatile LAS unsigned* st; };
DI XcdBarrier xcd_barrier_post(unsigned* bar, volatile LAS unsigned* st) {
    XcdBarrier b; b.bar = bar; b.x = xb_xcc_id(); b.st = st;
    if (threadIdx.x == 0) (void)xb_add(&bar[XB_XCNT(b.x)], 1u);
    return b;
}
DI void xcd_barrier_complete(unsigned* bar, unsigned x, unsigned& nloc, unsigned& nx) {
    const unsigned G = gridDim.x * gridDim.y * gridDim.z;
    unsigned sum, cnt, mine, sp = 0u;
    for (;;) {
        sum = 0u; cnt = 0u; mine = 0u;
#pragma unroll
        for (unsigned j = 0; j < 16; ++j) { const unsigned c = xb_ld(&bar[XB_XCNT(j)]); sum += c; cnt += (c > 0u) ? 1u : 0u; mine = (j == x) ? c : mine; }
        if (sum == G) break;
        __builtin_amdgcn_s_sleep(1);
        if ((++sp & 255u) == 0u) { if (xb_ld(&bar[XB_TMO])) break; if (sp > XB_SPIN_CAP) { atomicAdd(&bar[XB_TMO], 1u); break; } }
    }
    nloc = mine > 0u ? mine : 1u; nx = cnt > 0u ? cnt : 1u;
}
DI void xcd_barrier(const XcdBarrier& b) {
    asm volatile("s_waitcnt vmcnt(0)" ::: "memory");
    __syncthreads();
    if (threadIdx.x == 0) {
        unsigned* bar = b.bar;
        __builtin_amdgcn_s_waitcnt(0);
        unsigned nloc = b.st[0], nx = b.st[1];
        if (nloc == 0u) { xcd_barrier_complete(bar, b.x, nloc, nx); b.st[0] = nloc; b.st[1] = nx; }
        const unsigned old = xb_add(&bar[XB_XSUB(b.x)], 1u);
        const unsigned gen = old / nloc;
        if (old + 1u == (gen + 1u) * nloc) {
            __builtin_amdgcn_fence(__ATOMIC_RELEASE, "agent");
            asm volatile("s_waitcnt vmcnt(0)" ::: "memory");
            const unsigned og = xb_add(&bar[XB_TOP], 1u);
            const unsigned tg = og / nx;
            if (og + 1u == (tg + 1u) * nx) xb_add(&bar[XB_TOPGEN], 1u);
            else XB_SPIN(xb_ld(&bar[XB_TOPGEN]) == tg, bar);
            __builtin_amdgcn_fence(__ATOMIC_ACQUIRE, "agent");
            xb_add(&bar[XB_XGEN(b.x)], 1u);
            asm volatile("s_waitcnt vmcnt(0)" ::: "memory");
        } else {
            XB_SPIN(xb_ld(&bar[XB_XGEN(b.x)]) == gen, bar);
            __builtin_amdgcn_fence(__ATOMIC_ACQUIRE, "agent");
            asm volatile("s_waitcnt vmcnt(0)" ::: "memory");
        }
    }
    __syncthreads();
}

struct Args { const float* in[21]; float* out; unsigned char* ws; int ph_lo, ph_hi; };
struct Frame {
    LAS unsigned char* lds;
    int tid, lane, wave, vcu, G;
    const float* in[21]; float* out; unsigned char* ws;
};
DI float wave_sum(float v) {
#pragma unroll
    for (int o = 1; o < 64; o <<= 1) v += __shfl_xor(v, o);
    return v;
}

template <class F> DI void wt_item(F val, int K, bf16* WT, int nblk, LAS float* scr, int item, int lane) {
    const int kb = item / nblk, nb = item % nblk, k0 = 64 * kb, n0 = 32 * nb;
#pragma unroll 1
    for (int hb = 0; hb < 2; ++hb) {
        float tmp[16];
#pragma unroll
        for (int i = 0; i < 16; ++i) tmp[i] = val(k0 + 32 * hb + 2 * i + (lane >> 5), n0 + (lane & 31));
#pragma unroll
        for (int i = 0; i < 16; ++i) scr[(32 * hb + 2 * i + (lane >> 5)) * 33 + (lane & 31)] = tmp[i];
    }
    LDS_WAIT(); asm volatile("" ::: "memory");
    const int c = lane & 7;
#pragma unroll
    for (int j = 0; j < 4; ++j) { const int n = (lane >> 3) + 8 * j; const LAS float* s = scr + (8 * c) * 33 + n;
        u32x4 o; o.x = pk2(s[0 * 33], s[1 * 33]); o.y = pk2(s[2 * 33], s[3 * 33]); o.z = pk2(s[4 * 33], s[5 * 33]); o.w = pk2(s[6 * 33], s[7 * 33]);
        *(u32x4*)(WT + (size_t)(n0 + n) * K + k0 + 8 * c) = o; }
    LDS_WAIT(); asm volatile("" ::: "memory");
}
DI void wt_item_y(const float* win, const float* pw, const float* ps, bf16* WT, LAS float* scr, int item, int lane) {
    const int kb = item / 16, nb = item % 16, k0 = 16 * kb, n0 = 32 * nb, n = n0 + (lane & 31), g = n >> 7, d = n & 127;
    float breg[128];
    { const float sc = ps[n]; const float* b = pw + (size_t)g * 16384 + d;
#pragma unroll
      for (int c = 0; c < 128; ++c) breg[c] = b[c * 128] * sc; }
#pragma unroll 1
    for (int i = 0; i < 8; i += 2) {
        const int kk0 = 2 * i + (lane >> 5), kk1 = kk0 + 2;
        const f32x4* a0 = (const f32x4*)(win + (size_t)(k0 + kk0) * WIN_LD + g * 128); const f32x4* a1 = (const f32x4*)(win + (size_t)(k0 + kk1) * WIN_LD + g * 128);
        f32x4 av0[32], av1[32];
#pragma unroll
        for (int c = 0; c < 32; ++c) { av0[c] = a0[c]; av1[c] = a1[c]; }
        float s0 = 0.f, s1 = 0.f, s2 = 0.f, s3 = 0.f, t0 = 0.f, t1 = 0.f, t2 = 0.f, t3 = 0.f;
#pragma unroll
        for (int c = 0; c < 32; ++c) { s0 += av0[c][0] * breg[4 * c]; s1 += av0[c][1] * breg[4 * c + 1]; s2 += av0[c][2] * breg[4 * c + 2]; s3 += av0[c][3] * breg[4 * c + 3];
                                       t0 += av1[c][0] * breg[4 * c]; t1 += av1[c][1] * breg[4 * c + 1]; t2 += av1[c][2] * breg[4 * c + 2]; t3 += av1[c][3] * breg[4 * c + 3]; }
        scr[kk0 * 33 + (lane & 31)] = (s0 + s1) + (s2 + s3); scr[kk1 * 33 + (lane & 31)] = (t0 + t1) + (t2 + t3); }
    LDS_WAIT(); asm volatile("" ::: "memory");
    { const int c = lane & 1, nn = lane >> 1; const LAS float* sp = scr + (8 * c) * 33 + nn;
      u32x4 o; o.x = pk2(sp[0 * 33], sp[1 * 33]); o.y = pk2(sp[2 * 33], sp[3 * 33]); o.z = pk2(sp[4 * 33], sp[5 * 33]); o.w = pk2(sp[6 * 33], sp[7 * 33]);
      *(u32x4*)(WT + (size_t)(n0 + nn) * DM + k0 + 8 * c) = o; }
    LDS_WAIT(); asm volatile("" ::: "memory");
}
template <int NR> DI void norm_rows_to_bf16(int lane, const float* x0, size_t rs, const f32x4 (&w)[4], bf16* o0) {
    f32x4 v[NR][4]; float s[NR];
#pragma unroll
    for (int q = 0; q < NR; ++q) { const f32x4* xr = (const f32x4*)(x0 + q * rs * DM) + lane;
#pragma unroll
        for (int j = 0; j < 4; ++j) v[q][j] = xr[64 * j]; }
#pragma unroll
    for (int q = 0; q < NR; ++q) { float t = 0.f;
#pragma unroll
        for (int j = 0; j < 4; ++j) t += (v[q][j].x * v[q][j].x + v[q][j].y * v[q][j].y) + (v[q][j].z * v[q][j].z + v[q][j].w * v[q][j].w);
        s[q] = t; }
#pragma unroll
    for (int o = 1; o < 64; o <<= 1) {
#pragma unroll
        for (int q = 0; q < NR; ++q) s[q] += __shfl_xor(s[q], o); }
#pragma unroll
    for (int q = 0; q < NR; ++q) { const float rstd = rsqrtf(s[q] * (1.f / DM) + EPS); u32x2* o8 = (u32x2*)(o0 + q * rs * DM) + lane;
#pragma unroll
        for (int j = 0; j < 4; ++j) { u32x2 o; o.x = cvtpk(v[q][j].x * rstd * w[j].x, v[q][j].y * rstd * w[j].y); o.y = cvtpk(v[q][j].z * rstd * w[j].z, v[q][j].w * rstd * w[j].w); o8[64 * j] = o; } }
}
DI void p0_prologue(Frame& F) {
    LAS float* scr = (LAS float*)(F.lds + RING_OFF + F.wave * 16384);
    const int gw = F.vcu * NWAVES + F.wave, NGW = F.G * NWAVES, lane = F.lane;
    const float* win = F.in[3]; const float* pw = F.in[4]; const float* ps = F.in[5]; const float* gw2 = F.in[6];
    const float* wout = F.in[9]; const float* nxw = F.in[10]; const float* wq = F.in[12]; const float* wkv = F.in[13]; const float* wxo = F.in[14];
    const float* nfw = F.in[15]; const float* wup = F.in[16]; const float* wdn = F.in[19];
    bf16* W1T = (bf16*)(F.ws + WS_W1T); bf16* WOT = (bf16*)(F.ws + WS_WOT); bf16* WQT = (bf16*)(F.ws + WS_WQT); bf16* WKT = (bf16*)(F.ws + WS_WKT);
    bf16* WVT = (bf16*)(F.ws + WS_WVT); bf16* WXOT = (bf16*)(F.ws + WS_WXOT); bf16* WUT = (bf16*)(F.ws + WS_WUT); bf16* WDT = (bf16*)(F.ws + WS_WDT);
    constexpr int I_Y = 64 * 16, I_QKV = 16 * 32, I_G = 16 * 8, I_R = 16 * 16, I_SQ = 16 * 32, I_UP = 16 * 176, I_DN = 44 * 32;
    constexpr int NITEMS = I_Y + I_QKV + I_G + I_R + 5 * I_SQ + I_UP + I_DN;
    for (int it = gw; it < NITEMS; it += NGW) {
        int r = it;
        if (r < I_Y) { wt_item_y(win, pw, ps, W1T, scr, r, lane); continue; } r -= I_Y;
        if (r < I_QKV) {
            wt_item([&](int k, int n) { const float v = win[(size_t)k * WIN_LD + 512 + n]; return n < 256 ? v * 0.125f : v; }, DM, W1T + (size_t)C_Q * DM, 32, scr, r, lane); continue; } r -= I_QKV;
        if (r < I_G) {
            wt_item([&](int k, int n) { const float* a = win + (size_t)k * WIN_LD + 1536; float s = 0.f;
#pragma unroll
                for (int c = 0; c < 16; ++c) s += a[c] * gw2[c * 256 + n];
                return s; }, DM, W1T + (size_t)C_LG * DM, 8, scr, r, lane); continue; } r -= I_G;
        if (r < I_R) { wt_item([&](int k, int n) { return win[(size_t)k * WIN_LD + 1552 + n]; }, DM, W1T + (size_t)C_SR * DM, 16, scr, r, lane); continue; } r -= I_R;
        if (r < I_SQ) { wt_item([&](int k, int n) { return wout[(size_t)k * DM + n]; }, DM, WOT, 32, scr, r, lane); continue; } r -= I_SQ;
        if (r < I_SQ) { wt_item([&](int k, int n) { return wq[(size_t)k * DM + n] * nxw[k]; }, DM, WQT, 32, scr, r, lane); continue; } r -= I_SQ;
        if (r < I_SQ) { wt_item([&](int k, int n) { return wkv[(size_t)k * 2048 + n]; }, DM, WKT, 32, scr, r, lane); continue; } r -= I_SQ;
        if (r < I_SQ) { wt_item([&](int k, int n) { return wkv[(size_t)k * 2048 + 1024 + n]; }, DM, WVT, 32, scr, r, lane); continue; } r -= I_SQ;
        if (r < I_SQ) { wt_item([&](int k, int n) { return wxo[(size_t)k * DM + n]; }, DM, WXOT, 32, scr, r, lane); continue; } r -= I_SQ;
        if (r < I_UP) {
            wt_item([&](int k, int n) { const int pn = n >> 8, bj = (n >> 7) & 1, j = n & 127; return wup[(size_t)k * NUP + bj * FF + pn * 128 + j] * nfw[k]; }, DM, WUT, 176, scr, r, lane); continue; } r -= I_UP;
        wt_item([&](int k, int n) { return wdn[(size_t)k * DM + n]; }, FF, WDT, 32, scr, r, lane);
    }
    { float* ss = (float*)(F.ws + WS_SS); for (int i = (F.vcu * 512 + F.tid); i < 3 * T; i += F.G * 512) ss[i] = 0.f; }
    { const float* w = F.in[2]; f32x4 wv[4];
#pragma unroll
      for (int j = 0; j < 4; ++j) wv[j] = ((const f32x4*)w)[lane + 64 * j];
      bf16* H1 = (bf16*)(F.ws + WS_H1);
      for (int m = gw; m < T; m += 4 * NGW) norm_rows_to_bf16<4>(lane, F.in[0] + (size_t)m * DM, (size_t)NGW, wv, H1 + (size_t)m * DM); }
    { const float* w = F.in[11]; f32x4 wv[4];
#pragma unroll
      for (int j = 0; j < 4; ++j) wv[j] = ((const f32x4*)w)[lane + 64 * j];
      bf16* MN = (bf16*)(F.ws + WS_MN);
      for (int m = gw; m < TM; m += 4 * NGW) norm_rows_to_bf16<4>(lane, F.in[1] + (size_t)m * DM, (size_t)NGW, wv, MN + (size_t)m * DM); }
}

DI int crow(int reg, int h) { return (reg & 3) + 8 * (reg >> 2) + 4 * h; }
#define MFMA32(a, b, c) __builtin_amdgcn_mfma_f32_32x32x16_bf16((a), (b), (c), 0, 0, 0)
constexpr int GP = 144;
template <int KSTEPS> DI void mma_tile(f32x16& acc, LAS const unsigned char* A, LAS const unsigned char* B, int lane) {
    const int r = lane & 31, h = lane >> 5;
    LAS const unsigned char* ap = A + r * GP + 16 * h; LAS const unsigned char* bp = B + r * GP + 16 * h;
    bf16x8 a[KSTEPS], b[KSTEPS];
#pragma unroll
    for (int ks = 0; ks < KSTEPS; ++ks) { a[ks] = *(const LAS bf16x8*)(ap + 32 * ks); b[ks] = *(const LAS bf16x8*)(bp + 32 * ks); }
#pragma unroll
    for (int ks = 0; ks < KSTEPS; ++ks) acc = MFMA32(a[ks], b[ks], acc);
}
DI void gla_item(Frame& F, int b, int h) {
    LAS unsigned char* L = F.lds;
    constexpr int QD = 0, KD = QD + 64 * GP, KET = KD + 64 * GP, VTL = KET + 64 * GP, SC = VTL + 128 * GP, STL = SC + 64 * GP, OL = STL + 128 * GP, OLP = 528,
                  DEC = OL + 64 * OLP, TOT = DEC + 256, GEND = TOT + 2048;
    static_assert(GEND <= RING_BYTES, "GLA LDS");
    const int tid = F.tid, lane = F.lane, wave = F.wave, r = lane & 31, hh = lane >> 5;
    const bf16* proj = (const bf16*)(F.ws + WS_PROJ); bf16* mix = (bf16*)(F.ws + WS_MIX); const float* gnw = F.in[8];
    for (int i = tid; i < 128 * GP / 4; i += 512) ((LAS unsigned*)(L + STL))[i] = 0u;
    f32x16 accS;
#pragma unroll
    for (int i = 0; i < 16; ++i) accS[i] = 0.f;
    const int it_o = wave >> 2, et_o = wave & 3, et_s = wave >> 1, dt_s = wave & 1;
    const int d = tid & 63, tg = tid >> 6, ev = tid & 127, tq = tid >> 7, i3 = tid >> 3, eg = tid & 7;
    float gn[16];
#pragma unroll
    for (int q = 0; q < 16; ++q) gn[q] = gnw[16 * eg + q];
    bf16 lgr[8], qr[8], kr[8], va[8], vb[8];
    const size_t seq0 = (size_t)b * SEQ;
#define GLA_LOAD(n_) do { const bf16* base_ = proj + (seq0 + 64 * (n_)) * N1; \
        _Pragma("unroll") for (int ii = 0; ii < 8; ++ii) { const bf16* rp = base_ + (size_t)(8 * tg + ii) * N1 + 64 * h + d; lgr[ii] = rp[C_LG]; qr[ii] = rp[C_Q]; kr[ii] = rp[C_K]; } \
        _Pragma("unroll") for (int jj = 0; jj < 8; ++jj) { const bf16* rp = base_ + (size_t)(16 * tq + 2 * jj) * N1 + C_V + 128 * h + ev; va[jj] = rp[0]; vb[jj] = rp[N1]; } } while (0)
    GLA_LOAD(0);
    __syncthreads();
    for (int n = 0; n < SEQ / 64; ++n) {
        const size_t tok0 = seq0 + 64 * n;
        const bf16* base = proj + tok0 * N1;
        const bf16* srp = base + (size_t)i3 * N1 + C_SR + 128 * h + 16 * eg;
        const u32x4 s0 = *(const u32x4*)srp, s1 = *(const u32x4*)(srp + 8);
        {
            float lgv[8], qv[8], kv[8];
#pragma unroll
            for (int ii = 0; ii < 8; ++ii) { lgv[ii] = bf2f(lgr[ii]); qv[ii] = bf2f(qr[ii]); kv[ii] = bf2f(kr[ii]); }
            { LAS u32x4* dst = (LAS u32x4*)(L + VTL + ev * GP + tq * 32);
              unsigned vr[8];
#pragma unroll
              for (int jj = 0; jj < 8; ++jj) vr[jj] = (unsigned)va[jj] | ((unsigned)vb[jj] << 16);
              dst[0] = (u32x4){vr[0], vr[1], vr[2], vr[3]}; dst[1] = (u32x4){vr[4], vr[5], vr[6], vr[7]}; }
#pragma unroll
            for (int ii = 1; ii < 8; ++ii) lgv[ii] += lgv[ii - 1];
            ((LAS float*)(L + TOT))[tg * 64 + d] = lgv[7];
            __syncthreads();
            float pre = 0.f, tot = 0.f;
#pragma unroll
            for (int g = 0; g < 8; ++g) { const float t = ((LAS float*)(L + TOT))[g * 64 + d]; tot += t; pre += (g < tg) ? t : 0.f; }
            unsigned kep[4];
#pragma unroll
            for (int ii = 0; ii < 8; ii += 2) {
                const float G0 = pre + lgv[ii], G1 = pre + lgv[ii + 1];
                const float q0 = qv[ii] * fexp(G0), q1 = qv[ii + 1] * fexp(G1);
                const float k0 = kv[ii] * fexp(-G0), k1 = kv[ii + 1] * fexp(-G1);
                const float e0 = kv[ii] * fexp(tot - G0), e1 = kv[ii + 1] * fexp(tot - G1);
                *(LAS bf16*)(L + QD + (8 * tg + ii) * GP + 2 * d) = (bf16)f2bf(q0); *(LAS bf16*)(L + QD + (8 * tg + ii + 1) * GP + 2 * d) = (bf16)f2bf(q1);
                *(LAS bf16*)(L + KD + (8 * tg + ii) * GP + 2 * d) = (bf16)f2bf(k0); *(LAS bf16*)(L + KD + (8 * tg + ii + 1) * GP + 2 * d) = (bf16)f2bf(k1);
                kep[ii >> 1] = cvtpk(e0, e1);
            }
            *(LAS u32x4*)(L + KET + d * GP + tg * 16) = (u32x4){kep[0], kep[1], kep[2], kep[3]};
            if (tg == 0) ((LAS float*)(L + DEC))[d] = fexp(tot);
        }
        __syncthreads();
        { const int nn = (n + 1 < SEQ / 64) ? n + 1 : n; GLA_LOAD(nn); }
        f32x16 acc_o;
#pragma unroll
        for (int i = 0; i < 16; ++i) acc_o[i] = 0.f;
        if (wave < 3) {
            const int it = (wave >= 1) ? 1 : 0, jt = (wave == 2) ? 1 : 0;
            f32x16 sc;
#pragma unroll
            for (int i = 0; i < 16; ++i) sc[i] = 0.f;
            mma_tile<4>(sc, L + QD + it * 32 * GP, L + KD + jt * 32 * GP, lane);
#pragma unroll
            for (int reg = 0; reg < 16; ++reg) { const int i = 32 * it + crow(reg, hh), j = 32 * jt + r; const float v = (j <= i) ? sc[reg] : 0.f; *(LAS bf16*)(L + SC + i * GP + 2 * j) = (bf16)f2bf(v); }
        }
        mma_tile<4>(acc_o, L + QD + it_o * 32 * GP, L + STL + et_o * 32 * GP, lane);
        { const float dec = ((LAS float*)(L + DEC))[32 * dt_s + r];
#pragma unroll
          for (int i = 0; i < 16; ++i) accS[i] *= dec;
          mma_tile<4>(accS, L + VTL + et_s * 32 * GP, L + KET + dt_s * 32 * GP, lane); }
        __syncthreads();
        if (it_o) mma_tile<4>(acc_o, L + SC + 32 * GP, L + VTL + et_o * 32 * GP, lane); else mma_tile<2>(acc_o, L + SC, L + VTL + et_o * 32 * GP, lane);
#pragma unroll
        for (int reg = 0; reg < 16; ++reg) {
            *(LAS bf16*)(L + STL + (32 * et_s + crow(reg, hh)) * GP + 2 * (32 * dt_s + r)) = (bf16)f2bf(accS[reg]);
            *(LAS float*)(L + OL + (32 * it_o + crow(reg, hh)) * OLP + 4 * (32 * et_o + r)) = acc_o[reg];
        }
        __syncthreads();
        {
            float o[16]; float s = 0.f;
#pragma unroll
            for (int q = 0; q < 4; ++q) { const f32x4 v = *(LAS const f32x4*)(L + OL + i3 * OLP + 64 * eg + 16 * q); o[4 * q] = v[0]; o[4 * q + 1] = v[1]; o[4 * q + 2] = v[2]; o[4 * q + 3] = v[3]; s += (v[0] * v[0] + v[1] * v[1]) + (v[2] * v[2] + v[3] * v[3]); }
            s += __shfl_xor(s, 1); s += __shfl_xor(s, 2); s += __shfl_xor(s, 4);
            const float rstd = rsqrtf(s * (1.f / 128.f) + EPS);
            const unsigned sw[8] = {s0.x, s0.y, s0.z, s0.w, s1.x, s1.y, s1.z, s1.w};
            unsigned ow[8];
#pragma unroll
            for (int q = 0; q < 8; ++q) ow[q] = cvtpk(o[2 * q] * rstd * gn[2 * q] * bflo(sw[q]), o[2 * q + 1] * rstd * gn[2 * q + 1] * bfhi(sw[q]));
            bf16* op = mix + (tok0 + i3) * DM + 512 + 128 * h + 16 * eg;
            *(u32x4*)op = (u32x4){ow[0], ow[1], ow[2], ow[3]}; *(u32x4*)(op + 8) = (u32x4){ow[4], ow[5], ow[6], ow[7]};
        }
    }
#undef GLA_LOAD
}
DI void pool_item(Frame& F, int item) {
    const int lane = F.lane, b = item >> 5, blk = item & 31, c0 = 8 * lane, w = 2 << (lane >> 4);
    const bf16* proj = (const bf16*)(F.ws + WS_PROJ); bf16* mix = (bf16*)(F.ws + WS_MIX);
    const size_t seq0 = (size_t)b * SEQ; const int p0 = 64 * blk;
    float s[8];
#pragma unroll
    for (int j = 0; j < 8; ++j) s[j] = 0.f;
    { u32x4 hv[15];
#pragma unroll
      for (int k = 1; k <= 15; ++k) { const int p = p0 - k; hv[k - 1] = (k <= w - 1 && p >= 0) ? *(const u32x4*)(proj + (seq0 + p) * N1 + c0) : (u32x4){0u, 0u, 0u, 0u}; }
#pragma unroll
      for (int k = 0; k < 15; ++k) { const u32x4 v = hv[k]; s[0] += bflo(v.x); s[1] += bfhi(v.x); s[2] += bflo(v.y); s[3] += bfhi(v.y); s[4] += bflo(v.z); s[5] += bfhi(v.z); s[6] += bflo(v.w); s[7] += bfhi(v.w); } }
#pragma unroll 1
    for (int tb = 0; tb < 64; tb += 8) {
        u32x4 yv[8], dv[8];
#pragma unroll
        for (int t = 0; t < 8; ++t) { const int p = p0 + tb + t, pd = p - w + 1; yv[t] = *(const u32x4*)(proj + (seq0 + p) * N1 + c0);
            dv[t] = (pd >= 0) ? *(const u32x4*)(proj + (seq0 + pd) * N1 + c0) : (u32x4){0u, 0u, 0u, 0u}; }
#pragma unroll
        for (int t = 0; t < 8; ++t) {
            const int p = p0 + tb + t; const u32x4 v = yv[t], u = dv[t];
            const float y[8] = {bflo(v.x), bfhi(v.x), bflo(v.y), bfhi(v.y), bflo(v.z), bfhi(v.z), bflo(v.w), bfhi(v.w)};
            const float inv = 1.f / (float)((p + 1) < w ? (p + 1) : w);
            float o[8];
#pragma unroll
            for (int j = 0; j < 8; ++j) { s[j] += y[j]; o[j] = s[j] * inv - y[j]; }
            *(u32x4*)(mix + (seq0 + p) * DM + c0) = (u32x4){cvtpk(o[0], o[1]), cvtpk(o[2], o[3]), cvtpk(o[4], o[5]), cvtpk(o[6], o[7])};
            s[0] -= bflo(u.x); s[1] -= bfhi(u.x); s[2] -= bflo(u.y); s[3] -= bfhi(u.y); s[4] -= bflo(u.z); s[5] -= bfhi(u.z); s[6] -= bflo(u.w); s[7] -= bfhi(u.w);
        }
    }
}

constexpr int ATT_PP = 1056, ATT_HALF = 64 * ATT_PP, ATT_LDS = 2 * ATT_HALF;
DI int swap23(int r) { return (r & ~12) | ((r & 4) << 1) | ((r & 8) >> 1); }
DI void attn_fill_half(LAS unsigned char* Lb, const bf16* src, size_t pitch_elems, int wave, int lane) {
    const unsigned loff = (unsigned)((lane & 1) * pitch_elems * 2 + (lane >> 1) * 16);
#pragma unroll
    for (int i = 0; i < 8; ++i) { const int p = wave * 8 + i;
        __builtin_amdgcn_global_load_lds((const unsigned*)((const char*)(src + (size_t)(2 * p) * pitch_elems) + loff), (LAS unsigned*)(Lb + p * ATT_PP), 16, 0, 0); }
}
static_assert(ATT_LDS <= LDSCTL_OFF, "attention LDS image");
DI void attn_units(Frame& F, int u0, int nu) {
    LAS unsigned char* L = F.lds;
    const int lane = F.lane, wave = F.wave, r = lane & 31, hh = lane >> 5;
    const bf16* Q = (const bf16*)(F.ws + WS_H1); const bf16* KB = (const bf16*)(F.ws + WS_KB); const bf16* VT = (const bf16*)(F.ws + WS_VT); bf16* O = (bf16*)(F.ws + WS_MIX);
    const int kr = swap23(r);
    LAS const unsigned char* kbase = L + (kr >> 1) * ATT_PP + (kr & 1) * 16 + 32 * hh;
    LAS const unsigned char* vbase = L + (r >> 1) * ATT_PP + (r & 1) * 16 + 32 * hh;
    bf16x8 qf[16];
#define ATT_DEC(u_) const int qb_ = (u_) & 7, bh_ = (u_) >> 3, b_ = bh_ >> 2, h_ = bh_ & 3
#define ATT_KSRC(u_, half_) (KB + ((size_t)((u_) >> 5) * NMEM + 128 * (half_)) * DM + 256 * (((u_) >> 3) & 3))
#define ATT_VSRC(u_, half_) (VT + (size_t)(256 * (((u_) >> 3) & 3) + 128 * (half_)) * TM + (size_t)((u_) >> 5) * NMEM)
#define ATT_QLOAD(u_) do { ATT_DEC(u_); const bf16* qp = Q + ((size_t)b_ * SEQ + 256 * qb_ + 32 * wave + r) * DM + 256 * h_ + 8 * hh; \
        _Pragma("unroll") for (int ks = 0; ks < 16; ++ks) qf[ks] = *(const bf16x8*)(qp + 16 * ks); } while (0)
    attn_fill_half(L, ATT_KSRC(u0, 0), DM, wave, lane);
    attn_fill_half(L + ATT_HALF, ATT_KSRC(u0, 1), DM, wave, lane);
    ATT_QLOAD(u0);
    VM_WAIT(); __syncthreads();
#pragma unroll 1
    for (int ui = 0; ui < nu; ++ui) {
        const int u = u0 + ui, un = (ui + 1 < nu) ? u + 1 : u;
        f32x16 sacc[8];
#pragma unroll
        for (int kt = 0; kt < 4; ++kt) {
#pragma unroll
            for (int i = 0; i < 16; ++i) sacc[kt][i] = 0.f;
#pragma unroll
            for (int ks = 0; ks < 16; ++ks) { const bf16x8 kf = *(LAS const bf16x8*)(kbase + kt * 16 * ATT_PP + 64 * ks); sacc[kt] = MFMA32(kf, qf[ks], sacc[kt]); }
        }
        VM_WAIT(); __syncthreads();
        attn_fill_half(L, ATT_VSRC(u, 0), TM, wave, lane);
#pragma unroll
        for (int kt = 4; kt < 8; ++kt) {
#pragma unroll
            for (int i = 0; i < 16; ++i) sacc[kt][i] = 0.f;
#pragma unroll
            for (int ks = 0; ks < 16; ++ks) { const bf16x8 kf = *(LAS const bf16x8*)(kbase + ATT_HALF + (kt - 4) * 16 * ATT_PP + 64 * ks); sacc[kt] = MFMA32(kf, qf[ks], sacc[kt]); }
        }
        VM_WAIT(); __syncthreads();
        attn_fill_half(L + ATT_HALF, ATT_VSRC(u, 1), TM, wave, lane);
        float mx = sacc[0][0];
#pragma unroll
        for (int kt = 0; kt < 8; ++kt)
#pragma unroll
            for (int i = 0; i < 16; ++i) mx = fmaxf(mx, sacc[kt][i]);
        mx = fmaxf(mx, __shfl_xor(mx, 32));
        float sum = 0.f;
        bf16x8 pf[8][2];
#pragma unroll
        for (int kt = 0; kt < 8; ++kt) {
#pragma unroll
            for (int i = 0; i < 16; ++i) { const float pv = __builtin_amdgcn_exp2f(sacc[kt][i] - mx); sacc[kt][i] = pv; sum += pv; }
#pragma unroll
            for (int s2 = 0; s2 < 2; ++s2) { u32x4 pw; pw.x = cvtpk(sacc[kt][8 * s2], sacc[kt][8 * s2 + 1]); pw.y = cvtpk(sacc[kt][8 * s2 + 2], sacc[kt][8 * s2 + 3]); pw.z = cvtpk(sacc[kt][8 * s2 + 4], sacc[kt][8 * s2 + 5]); pw.w = cvtpk(sacc[kt][8 * s2 + 6], sacc[kt][8 * s2 + 7]);
                pf[kt][s2] = __builtin_bit_cast(bf16x8, pw); }
        }
        sum += __shfl_xor(sum, 32);
        const float inv = 1.f / sum;
        ATT_DEC(u);
        bf16* op = O + ((size_t)b_ * SEQ + 256 * qb_ + 32 * wave + r) * DM + 256 * h_ + 4 * hh;
#pragma unroll 1
        for (int dt = 0; dt < 4; ++dt) {
            f32x16 oacc;
#pragma unroll
            for (int i = 0; i < 16; ++i) oacc[i] = 0.f;
#pragma unroll
            for (int kt = 0; kt < 8; ++kt)
#pragma unroll
                for (int s2 = 0; s2 < 2; ++s2) { const bf16x8 vf = *(LAS const bf16x8*)(vbase + dt * 16 * ATT_PP + 64 * (2 * kt + s2)); oacc = MFMA32(vf, pf[kt][s2], oacc); }
#pragma unroll
            for (int g = 0; g < 4; ++g) { u32x2 w; w.x = cvtpk(oacc[4 * g] * inv, oacc[4 * g + 1] * inv); w.y = cvtpk(oacc[4 * g + 2] * inv, oacc[4 * g + 3] * inv); *(u32x2*)(op + 32 * dt + 8 * g) = w; }
        }
        VM_WAIT(); __syncthreads();
        attn_fill_half(L, ATT_KSRC(un, 0), DM, wave, lane);
        ATT_QLOAD(un);
#pragma unroll 1
        for (int dt = 0; dt < 4; ++dt) {
            f32x16 oacc;
#pragma unroll
            for (int i = 0; i < 16; ++i) oacc[i] = 0.f;
#pragma unroll
            for (int kt = 0; kt < 8; ++kt)
#pragma unroll
                for (int s2 = 0; s2 < 2; ++s2) { const bf16x8 vf = *(LAS const bf16x8*)(vbase + ATT_HALF + dt * 16 * ATT_PP + 64 * (2 * kt + s2)); oacc = MFMA32(vf, pf[kt][s2], oacc); }
#pragma unroll
            for (int g = 0; g < 4; ++g) { u32x2 w; w.x = cvtpk(oacc[4 * g] * inv, oacc[4 * g + 1] * inv); w.y = cvtpk(oacc[4 * g + 2] * inv, oacc[4 * g + 3] * inv); *(u32x2*)(op + 128 + 32 * dt + 8 * g) = w; }
        }
        VM_WAIT(); __syncthreads();
        attn_fill_half(L + ATT_HALF, ATT_KSRC(un, 1), DM, wave, lane);
    }
    VM_WAIT(); __syncthreads();
#undef ATT_DEC
#undef ATT_KSRC
#undef ATT_VSRC
#undef ATT_QLOAD
}

DI void conv_fixup(Frame& F) {
    const bf16* HF = (const bf16*)(F.ws + WS_HF); const bf16* HL = (const bf16*)(F.ws + WS_HL); bf16* ACT = (bf16*)(F.ws + WS_ACT);
    const float* cw = F.in[17]; const float* cb = F.in[18];
    constexpr int NCG = FF / 8, NITEM = (T / 64) * 2 * NCG;
    for (int item = F.vcu * 512 + F.tid; item < NITEM; item += F.G * 512) {
        const int rr = item / NCG, cg = item - rr * NCG, blk = rr >> 1, rho = rr & 1, ca = 8 * cg, pn = ca >> 7, j = ca & 127, ucol = 256 * pn + j;
        const bool first = (blk & 31) == 0;
        const bf16* p0 = HF + ((size_t)blk * 2 + rho) * NUP + ucol;
        const bf16* p1 = rho ? HF + ((size_t)blk * 2) * NUP + ucol : HL + ((size_t)(blk - 1) * 2 + 1) * NUP + ucol;
        const bf16* p2 = rho ? HL + ((size_t)(blk - 1) * 2 + 1) * NUP + ucol : HL + ((size_t)(blk - 1) * 2) * NUP + ucol;
        const bool z1 = first && !rho, z2 = first;
        const u32x4 zero = (u32x4){0u, 0u, 0u, 0u};
        const u32x4 a0 = *(const u32x4*)p0, b0 = *(const u32x4*)(p0 + 128);
        const u32x4 a1 = z1 ? zero : *(const u32x4*)p1, b1 = z1 ? zero : *(const u32x4*)(p1 + 128);
        const u32x4 a2 = z2 ? zero : *(const u32x4*)p2, b2 = z2 ? zero : *(const u32x4*)(p2 + 128);
        const unsigned g0w[4] = {a0.x, a0.y, a0.z, a0.w}, v0w[4] = {b0.x, b0.y, b0.z, b0.w}, g1w[4] = {a1.x, a1.y, a1.z, a1.w}, v1w[4] = {b1.x, b1.y, b1.z, b1.w}, g2w[4] = {a2.x, a2.y, a2.z, a2.w}, v2w[4] = {b2.x, b2.y, b2.z, b2.w};
        unsigned ow[4];
#pragma unroll
        for (int q = 0; q < 4; ++q) {
            float o[2];
#pragma unroll
            for (int e = 0; e < 2; ++e) { const int c = ca + 2 * q + e;
                const float g0 = e ? bfhi(g0w[q]) : bflo(g0w[q]), g1 = e ? bfhi(g1w[q]) : bflo(g1w[q]), g2 = e ? bfhi(g2w[q]) : bflo(g2w[q]);
                const float v0 = e ? bfhi(v0w[q]) : bflo(v0w[q]), v1 = e ? bfhi(v1w[q]) : bflo(v1w[q]), v2 = e ? bfhi(v2w[q]) : bflo(v2w[q]);
                const float gg = cb[c] + cw[c] * g2 + cw[NUP + c] * g1 + cw[2 * NUP + c] * g0;
                const float vv = cb[FF + c] + cw[FF + c] * v2 + cw[NUP + FF + c] * v1 + cw[2 * NUP + FF + c] * v0;
                o[e] = gg * __builtin_amdgcn_rcpf(1.f + __expf(-gg)) * vv; }
            ow[q] = cvtpk(o[0], o[1]);
        }
        *(u32x4*)(ACT + ((size_t)blk * 64 + rho) * FF + ca) = (u32x4){ow[0], ow[1], ow[2], ow[3]};
    }
}

DI void final_norm(Frame& F) {
    const int gw = F.vcu * NWAVES + F.wave, NGW = F.G * NWAVES, lane = F.lane;
    const float* ss = (const float*)(F.ws + WS_SS) + 2 * T; const float* w = F.in[20];
    f32x4 wv[4];
#pragma unroll
    for (int j = 0; j < 4; ++j) wv[j] = ((const f32x4*)w)[lane + 64 * j];
    for (int m = gw; m < T; m += NGW) {
        const float rstd = rsqrtf(ss[m] * (1.f / DM) + EPS);
        f32x4* p = (f32x4*)(F.out + (size_t)m * DM) + lane;
#pragma unroll
        for (int j = 0; j < 4; ++j) { f32x4 v = p[64 * j]; v = v * rstd * wv[j]; p[64 * j] = v; }
    }
}

__global__ void __launch_bounds__(NWAVES * 64, 2) hymba_fwd(Args args) {
    extern __shared__ __attribute__((aligned(16))) unsigned char lds[];
    Frame F;
    F.lds = (LAS unsigned char*)lds;
    F.tid = threadIdx.x; F.lane = F.tid & 63; F.wave = __builtin_amdgcn_readfirstlane(F.tid >> 6);
    F.G = gridDim.x; { const int bx = blockIdx.x; F.vcu = (F.G % 8 == 0) ? (bx % 8) * (F.G / 8) + bx / 8 : bx; }
#pragma unroll
    for (int i = 0; i < 21; ++i) F.in[i] = args.in[i];
    F.out = args.out; F.ws = args.ws;
    volatile LAS unsigned* MISC = (volatile LAS unsigned*)(F.lds + MISC_OFF);
    for (int u = F.tid; u < (LDS_BYTES - LDSCTL_OFF) / 4; u += NWAVES * 64) ((LAS unsigned*)(F.lds + LDSCTL_OFF))[u] = 0u;
    __syncthreads();
    const int lo = args.ph_lo, hi = args.ph_hi;
    XcdBarrier bar; bar.bar = (unsigned*)(F.ws + WS_CTL) + CW_BAR; bar.x = 0; bar.st = nullptr;
    if (hi - lo > 1) bar = xcd_barrier_post((unsigned*)(F.ws + WS_CTL) + CW_BAR, MISC + 8);
#define IN(k) (lo <= (k) && (k) < hi)
    unsigned long long pr_acc = 0, pr_t0 = 0;
#define RT_NOW(t) asm volatile("s_memrealtime %0\n\ts_waitcnt lgkmcnt(0)" : "=s"(t) :: "memory")
#define PB(k) do { if ((PROBE_MASK >> (k)) & 1) { RT_NOW(pr_t0); } } while (0)
#define SEAM(k) do { if (IN(k) && IN((k) + 1)) xcd_barrier(bar); if ((PROBE_MASK >> (k)) & 1) { unsigned long long t1_; RT_NOW(t1_); pr_acc += t1_ - pr_t0; } } while (0)
    const int cid = (int)blockIdx.x;
    bf16* W1T = (bf16*)(F.ws + WS_W1T); bf16* WOT = (bf16*)(F.ws + WS_WOT); bf16* WQT = (bf16*)(F.ws + WS_WQT); bf16* WKT = (bf16*)(F.ws + WS_WKT);
    bf16* WVT = (bf16*)(F.ws + WS_WVT); bf16* WXOT = (bf16*)(F.ws + WS_WXOT); bf16* WUT = (bf16*)(F.ws + WS_WUT); bf16* WDT = (bf16*)(F.ws + WS_WDT);
    bf16* H1 = (bf16*)(F.ws + WS_H1); bf16* PROJ = (bf16*)(F.ws + WS_PROJ); bf16* MIX = (bf16*)(F.ws + WS_MIX); bf16* X1B = (bf16*)(F.ws + WS_X1B);
    bf16* MN = (bf16*)(F.ws + WS_MN); bf16* KB = (bf16*)(F.ws + WS_KB); bf16* VT = (bf16*)(F.ws + WS_VT); bf16* ACT = (bf16*)(F.ws + WS_ACT);
    float* SS1 = (float*)(F.ws + WS_SS); float* SS2 = SS1 + T; float* SS3 = SS2 + T;

    PB(0); if (IN(0)) { p0_prologue(F); } SEAM(0);
    PB(1); if (IN(1)) {
        { pg8::Gemm g{H1, W1T, T, N1, DM}; pg8::StaticOrder S; S.init(T, N1, F.G, cid); pg8::EpiG1 E{PROJ, F.in[7]};
          pg8::gemm_phase<pg8::EpiG1, pg8::StaticOrder, PG8_ALIGN, PG8_SP2>(F.lds + RING_OFF, g, S, E); }
    } SEAM(1);
    PB(2); if (IN(2)) {
        if (cid < 128) gla_item(F, cid >> 2, cid & 3);
        else { for (int item = (cid - 128) * NWAVES + F.wave; item < NB * (SEQ / 64); item += (F.G - 128) * NWAVES) pool_item(F, item);
            __syncthreads();
            { pg8::Gemm g{MN, WKT, TM, DM, DM}; pg8::StaticOrder S; S.init(TM, DM, F.G - 128, cid - 128); pg8::EpiBf16<false> E{KB, DM, nullptr, 1.f};
              pg8::gemm_phase<pg8::EpiBf16<false>, pg8::StaticOrder, PG8_ALIGN, PG8_SP2>(F.lds + RING_OFF, g, S, E); }
            { pg8::Gemm g{WVT, MN, DM, TM, DM}; pg8::StaticOrder S; S.init(DM, TM, F.G - 128, cid - 128); pg8::EpiBf16<false> E{VT, TM, nullptr, 1.f};
              pg8::gemm_phase<pg8::EpiBf16<false>, pg8::StaticOrder, PG8_ALIGN, PG8_SP2>(F.lds + RING_OFF, g, S, E); } }
    } SEAM(2);
    PB(3); if (IN(3)) { pg8::Gemm g{MIX, WOT, T, DM, DM}; pg8::StaticOrder S; S.init(T, DM, F.G, cid); pg8::EpiRes<true> E{F.in[0], X1B, SS1};
        pg8::gemm_phase<pg8::EpiRes<true>, pg8::StaticOrder, PG8_ALIGN, PG8_SP2>(F.lds + RING_OFF, g, S, E); } SEAM(3);
    PB(4); if (IN(4)) { pg8::Gemm g{X1B, WQT, T, DM, DM}; pg8::StaticOrder S; S.init(T, DM, F.G, cid); pg8::EpiBf16<true> E{H1, DM, SS1, 0.0625f * LOG2E};
        pg8::gemm_phase<pg8::EpiBf16<true>, pg8::StaticOrder, PG8_ALIGN, PG8_SP2>(F.lds + RING_OFF, g, S, E); } SEAM(4);
    PB(5); if (IN(5)) { attn_units(F, F.vcu * 4, 4); } SEAM(5);
    PB(6); if (IN(6)) { pg8::Gemm g{MIX, WXOT, T, DM, DM}; pg8::StaticOrder S; S.init(T, DM, F.G, cid); pg8::EpiRes<false> E{X1B, X1B, SS2};
        pg8::gemm_phase<pg8::EpiRes<false>, pg8::StaticOrder, PG8_ALIGN, PG8_SP2>(F.lds + RING_OFF, g, S, E); } SEAM(6);
    PB(7); if (IN(7)) { pg8::Gemm g{X1B, WUT, T, NUP, DM}; pg8::StaticOrder S; S.init(T, NUP, F.G, cid);
        pg8::EpiConv E{ACT, (bf16*)(F.ws + WS_HF), (bf16*)(F.ws + WS_HL), SS2, F.in[17], F.in[18]};
        pg8::gemm_phase<pg8::EpiConv, pg8::StaticOrder, PG8_ALIGN, PG8_SP2>(F.lds + RING_OFF, g, S, E); } SEAM(7);
    PB(8); if (IN(8)) { conv_fixup(F); } SEAM(8);
    PB(9); if (IN(9)) { pg8::Gemm g{ACT, WDT, T, DM, FF}; pg8::StaticOrder S; S.init(T, DM, F.G, cid); pg8::EpiOut E{X1B, F.out, SS3};
        pg8::gemm_phase<pg8::EpiOut, pg8::StaticOrder, PG8_ALIGN, PG8_SP2>(F.lds + RING_OFF, g, S, E); } SEAM(9);
    PB(10); if (IN(10)) { final_norm(F); }
    if (PROBE_MASK) { if ((PROBE_MASK >> 10) & 1) { unsigned long long t1_; RT_NOW(t1_); pr_acc += t1_ - pr_t0; }
        if (blockIdx.x == 0 && F.tid == 0) { unsigned long long ta, tb; RT_NOW(ta); for (;;) { RT_NOW(tb); if (tb - ta >= pr_acc) break; __builtin_amdgcn_s_sleep(8); } } }
#undef IN
#undef SEAM
}

extern "C" void kernel_launch(void* const* d_in, const int* in_sizes, int n_in, void* d_out, int out_size, void* d_ws, size_t ws_size, hipStream_t stream) {
    static int grid = 0;
    if (grid == 0) {
        if (n_in != 21 || in_sizes[0] != T * DM || out_size != T * DM || ws_size < WS_END) { fprintf(stderr, "kernel_launch: unexpected shapes (n_in %d, in0 %d, out %d, ws %zu)\n", n_in, n_in > 0 ? in_sizes[0] : -1, out_size, ws_size); grid = -1; return; }
        int dev = 0, cus = 0;
        if (hipGetDevice(&dev) != hipSuccess || hipDeviceGetAttribute(&cus, hipDeviceAttributeMultiprocessorCount, dev) != hipSuccess) { grid = -1; return; }
        if (hipFuncSetAttribute((const void*)hymba_fwd, hipFuncAttributeMaxDynamicSharedMemorySize, LDS_BYTES) != hipSuccess) { fprintf(stderr, "kernel_launch: hipFuncSetAttribute failed\n"); grid = -1; return; }
        (void)hipGetLastError();
        grid = 256; if (cus != 256) fprintf(stderr, "kernel_launch: device reports %d CUs; built for 256\n", cus);
    }
    if (grid < 0) return;
    hipMemsetAsync((char*)d_ws + WS_CTL, 0, CTL_ZERO_BYTES, stream);
    Args a{};
    for (int i = 0; i < 21; ++i) a.in[i] = (const float*)d_in[i];
    a.out = (float*)d_out; a.ws = (unsigned char*)d_ws;
#if MK_SINGLE
    a.ph_lo = 0; a.ph_hi = NPHASE;
    hipLaunchKernelGGL(hymba_fwd, dim3(grid), dim3(NWAVES * 64), LDS_BYTES, stream, a);
#else
    for (int p = 0; p < NPHASE; ++p) { a.ph_lo = p; a.ph_hi = p + 1; hipLaunchKernelGGL(hymba_fwd, dim3(grid), dim3(NWAVES * 64), LDS_BYTES, stream, a); }
#endif
}
```
